# Optimizing an MI355X kernel written in HIP

```python
import math
import jax, jax.numpy as jnp
from jax import lax
import numpy as np

D_MODEL = 1024
BATCH = 8
SEQ = 4096
DEPTH = 4

N_MIXERS = 3
N_A_LAYERS = (DEPTH + 2) // 3
N_B_LAYERS = (DEPTH + 1) // 3
N_C_LAYERS = DEPTH // 3
HEAD_DIM = 64
EPS = 1e-6

A_GROUPS = ((128, 1), (512, 4), (2048, 16))
A_N_GROUPS = len(A_GROUPS)
A_HEADS = 8
A_BLOCK = 128
A_IN = 3 * A_N_GROUPS * A_HEADS * HEAD_DIM
A_OUT = A_HEADS * HEAD_DIM

B_HEADS = 16
B_KV_HEADS = 4
B_IDX_HEADS = 8
B_IDX_DIM = 64
B_TOPK_MAX = 256
B_BLOCK = 128
B_SPLITS = (B_HEADS * HEAD_DIM, B_KV_HEADS * HEAD_DIM, B_KV_HEADS * HEAD_DIM,
            B_IDX_HEADS * B_IDX_DIM, B_IDX_DIM, B_IDX_HEADS)
B_IN = sum(B_SPLITS)
B_OUT = B_HEADS * HEAD_DIM

C_HEADS = 8
C_KDIM = 128
C_VDIM = 128
C_CONV = 4
C_CHUNK = 64
C_CONV_CH = 2 * C_HEADS * C_KDIM + C_HEADS * C_VDIM
C_SPLITS = (C_CONV_CH, C_HEADS * C_VDIM, C_HEADS, C_HEADS)
C_IN = sum(C_SPLITS)
C_OUT = C_HEADS * C_VDIM

D_FF = 4 * D_MODEL

NUM_BUCKETS = 32
MAX_DISTANCE = 2048
A_BIAS_COLS = A_N_GROUPS * A_HEADS
N_BIAS_COLS = A_BIAS_COLS + B_HEADS

kernel_name = 'hybrid_dilated_dsa_gdn_block'


def rms_norm(x, gain):
    xf = x.astype(jnp.float32)
    y = xf * lax.rsqrt(jnp.mean(xf * xf, axis=-1, keepdims=True) + EPS)
    return (y * gain.astype(jnp.float32)).astype(x.dtype)


def l2_norm(x):
    xf = x.astype(jnp.float32)
    return xf * lax.rsqrt(jnp.sum(xf * xf, axis=-1, keepdims=True) + EPS)


def split_last(t, sizes):
    return jnp.split(t, np.cumsum(sizes)[:-1].tolist(), axis=-1)


def t5_bucket(dist):
    max_exact = NUM_BUCKETS // 2
    d = jnp.maximum(dist, 1).astype(jnp.float32)
    log_part = jnp.log(d / max_exact) / math.log(MAX_DISTANCE / max_exact) * (NUM_BUCKETS - max_exact)
    large = jnp.minimum(max_exact + log_part.astype(jnp.int32), NUM_BUCKETS - 1)
    return jnp.where(dist < max_exact, dist, large)


def squared_relu_mlp(h, w1, w2):
    return jnp.square(jax.nn.relu(h @ w1)) @ w2


def dilated_window_attention(q, k, v, bias_tab, window, dilation):
    B, S, H, Dh = q.shape
    n_back = window // dilation
    sub = S // dilation
    blk = math.gcd(A_BLOCK, sub)
    nb = sub // blk
    width = blk + n_back

    def to_sub(t):
        return t.reshape(B, sub, dilation, H, Dh).transpose(0, 2, 1, 3, 4)

    qs = to_sub(q).reshape(B, dilation, nb, blk, H, Dh)
    pad = ((0, 0), (0, 0), (n_back, 0), (0, 0), (0, 0))
    ks = jnp.pad(to_sub(k), pad)
    vs = jnp.pad(to_sub(v), pad)
    win = jnp.arange(nb)[:, None] * blk + jnp.arange(width)[None, :]
    kb = ks[:, :, win]
    vb = vs[:, :, win]
    logits = jnp.einsum('brnqhd,brnkhd->brnhqk', qs, kb).astype(jnp.float32) * (Dh ** -0.5)
    step = jnp.arange(blk)[:, None] - jnp.arange(width)[None, :] + n_back
    key_sub = win[:, None, :] - n_back
    valid = (step >= 0) & (step <= n_back) & (key_sub >= 0)
    bias = bias_tab[t5_bucket(jnp.maximum(step, 0) * dilation)]
    logits = logits + bias.transpose(2, 0, 1).astype(jnp.float32)
    logits = jnp.where(valid[:, None], logits, -jnp.inf)
    m = jnp.max(logits, axis=-1, keepdims=True)
    p = jnp.exp(logits - m)
    s = jnp.sum(p, axis=-1, keepdims=True)
    o = jnp.einsum('brnhqk,brnkhd->brnqhd', (p / s).astype(v.dtype), vb)
    lse = (m + jnp.log(s))[..., 0]
    o = o.reshape(B, dilation, sub, H, Dh).transpose(0, 2, 1, 3, 4).reshape(B, S, H, Dh)
    lse = lse.transpose(0, 1, 2, 4, 3).reshape(B, dilation, sub, H).transpose(0, 2, 1, 3).reshape(B, S, H)
    return o.astype(jnp.float32), lse


def mixer_a(h, w_in, q_gain, k_gain, w_out, bias_tab):
    B, S, _ = h.shape
    qkv = (h @ w_in).reshape(B, S, 3, A_N_GROUPS, A_HEADS, HEAD_DIM)
    q = rms_norm(qkv[:, :, 0], q_gain)
    k = rms_norm(qkv[:, :, 1], k_gain)
    v = qkv[:, :, 2]
    outs, lses = [], []
    for g, (window, dilation) in enumerate(A_GROUPS):
        o, lse = dilated_window_attention(q[:, :, g], k[:, :, g], v[:, :, g],
                                          bias_tab[:, g * A_HEADS:(g + 1) * A_HEADS], window, dilation)
        outs.append(o)
        lses.append(lse)
    wts = jax.nn.softmax(jnp.stack(lses), axis=0)
    y = jnp.sum(wts[..., None] * jnp.stack(outs), axis=0)
    return y.reshape(B, S, A_OUT).astype(h.dtype) @ w_out


def mixer_b(h, w_in, q_gain, k_gain, w_out, bias_tab):
    B, S, _ = h.shape
    q, k, v, q_idx, k_idx, w_idx = split_last(h @ w_in, B_SPLITS)
    q = rms_norm(q.reshape(B, S, B_HEADS, HEAD_DIM), q_gain)
    k = rms_norm(k.reshape(B, S, B_KV_HEADS, HEAD_DIM), k_gain)
    v = v.reshape(B, S, B_KV_HEADS, HEAD_DIM)
    q_idx = q_idx.reshape(B, S, B_IDX_HEADS, B_IDX_DIM)
    w_idx = w_idx * (B_IDX_HEADS ** -0.5)
    topk = min(B_TOPK_MAX, S // 4)
    nb = S // B_BLOCK
    grp = B_HEADS // B_KV_HEADS
    bidx = jnp.arange(B)[:, None, None]

    def blocks(t):
        return t.reshape(B, nb, B_BLOCK, *t.shape[2:]).swapaxes(0, 1)

    def one_block(args):
        blk_id, qb, qib, wb = args
        t = blk_id * B_BLOCK + jnp.arange(B_BLOCK)
        sc = jnp.einsum('bqhd,bsd->bqhs', qib, k_idx).astype(jnp.float32) * (B_IDX_DIM ** -0.5)
        score = jnp.einsum('bqh,bqhs->bqs', wb.astype(jnp.float32), jax.nn.relu(sc))
        causal = jnp.arange(S)[None, :] <= t[:, None]
        score = jnp.where(causal[None], score, -jnp.inf)
        _, sel = lax.top_k(score, topk)
        valid = sel <= t[None, :, None]
        ks = k[bidx, sel]
        vs = v[bidx, sel]
        qg = qb.reshape(B, B_BLOCK, B_KV_HEADS, grp, HEAD_DIM)
        logits = jnp.einsum('bqhgd,bqkhd->bqhgk', qg, ks).astype(jnp.float32) * (HEAD_DIM ** -0.5)
        dist = jnp.maximum(t[None, :, None] - sel, 0)
        bias = bias_tab[t5_bucket(dist)].astype(jnp.float32)
        bias = bias.reshape(B, B_BLOCK, topk, B_KV_HEADS, grp).transpose(0, 1, 3, 4, 2)
        logits = jnp.where(valid[:, :, None, None, :], logits + bias, -jnp.inf)
        p = jax.nn.softmax(logits, axis=-1)
        o = jnp.einsum('bqhgk,bqkhd->bqhgd', p.astype(vs.dtype), vs)
        return o.reshape(B, B_BLOCK, B_OUT)

    out = lax.map(one_block, (jnp.arange(nb), blocks(q), blocks(q_idx), blocks(w_idx)))
    out = out.swapaxes(0, 1).reshape(B, S, B_OUT)
    return out @ w_out


def chunk_gated_delta_rule(q, k, v, g, beta):
    B, S, H, Dk = q.shape
    Dv = v.shape[-1]
    C = math.gcd(C_CHUNK, S)
    n = S // C

    def chunks(t):
        return t.astype(jnp.float32).reshape(B, n, C, H, -1).transpose(1, 0, 3, 2, 4)

    q, k, v = chunks(q), chunks(k), chunks(v)
    g = g.astype(jnp.float32).reshape(B, n, C, H).transpose(1, 0, 3, 2)
    beta = beta.astype(jnp.float32).reshape(B, n, C, H).transpose(1, 0, 3, 2)
    gc = jnp.cumsum(g, axis=-1)
    diff = gc[..., :, None] - gc[..., None, :]
    lower = jnp.tril(jnp.ones((C, C), dtype=bool))
    strict = jnp.tril(jnp.ones((C, C), dtype=bool), -1)
    decay = jnp.where(lower, jnp.exp(jnp.where(lower, diff, 0.0)), 0.0)
    kb = k * beta[..., None]
    a_mat = jnp.where(strict, jnp.einsum('nbhid,nbhjd->nbhij', kb, k) * decay, 0.0)
    eye = jnp.broadcast_to(jnp.eye(C, dtype=jnp.float32), a_mat.shape)
    t_mat = lax.linalg.triangular_solve(a_mat, eye, left_side=True, lower=True, unit_diagonal=True)
    u = t_mat @ (v * beta[..., None])
    w = t_mat @ (kb * jnp.exp(gc)[..., None])
    qk = jnp.where(lower, jnp.einsum('nbhid,nbhjd->nbhij', q, k) * decay, 0.0)

    def step(state, xs):
        qi, ki, ui, wi, gci, qki = xs
        v_new = ui - wi @ state
        o = (qi * jnp.exp(gci)[..., None]) @ state + qki @ v_new
        g_last = gci[..., -1:]
        state = state * jnp.exp(g_last)[..., None] + jnp.einsum(
            'bhcd,bhce->bhde', ki * jnp.exp(g_last - gci)[..., None], v_new)
        return state, o

    state0 = jnp.zeros((B, H, Dk, Dv), jnp.float32)
    _, o = lax.scan(step, state0, (q, k, u, w, gc, qk))
    return o.transpose(1, 0, 3, 2, 4).reshape(B, S, H, Dv)


def mixer_c(h, w_in, conv_w, a_log, dt_bias, o_gain, w_out):
    B, S, _ = h.shape
    qkv, gate, b, a = split_last(h @ w_in, C_SPLITS)
    xpad = jnp.pad(qkv, ((0, 0), (C_CONV - 1, 0), (0, 0)))
    conv = sum(conv_w[j] * xpad[:, j:j + S] for j in range(C_CONV))
    conv = jax.nn.silu(conv)
    q, k, v = split_last(conv, (C_HEADS * C_KDIM, C_HEADS * C_KDIM, C_HEADS * C_VDIM))
    q = l2_norm(q.reshape(B, S, C_HEADS, C_KDIM)) * (C_KDIM ** -0.5)
    k = l2_norm(k.reshape(B, S, C_HEADS, C_KDIM))
    v = v.reshape(B, S, C_HEADS, C_VDIM)
    beta = jax.nn.sigmoid(b.astype(jnp.float32))
    g = -jnp.exp(a_log.astype(jnp.float32)) * jax.nn.softplus(a.astype(jnp.float32) + dt_bias.astype(jnp.float32))
    o = chunk_gated_delta_rule(q, k, v, g, beta)
    o = rms_norm(o, o_gain) * jax.nn.silu(gate.reshape(B, S, C_HEADS, C_VDIM).astype(jnp.float32))
    return o.reshape(B, S, C_OUT).astype(h.dtype) @ w_out


def setup_inputs(seed: int = 0) -> dict:
    key = jax.random.key(seed)
    ks = jax.random.split(key, 21)

    def nrm(k, shape, scale):
        return jax.random.normal(k, shape, jnp.float32) * scale

    def gain(k, shape):
        return 1.0 + 0.05 * jax.random.normal(k, shape, jnp.float32)

    dt = jnp.exp(jax.random.uniform(ks[20], (N_C_LAYERS, C_HEADS), jnp.float32, math.log(1e-3), math.log(1e-1)))
    return {
        'x': nrm(ks[0], (BATCH, SEQ, D_MODEL), 1.0),
        'rel_bias': nrm(ks[1], (NUM_BUCKETS, N_BIAS_COLS), 0.5),
        'norm_mix': gain(ks[2], (DEPTH, D_MODEL)),
        'norm_mlp': gain(ks[3], (DEPTH, D_MODEL)),
        'mlp_w1': nrm(ks[4], (DEPTH, D_MODEL, D_FF), D_MODEL ** -0.5),
        'mlp_w2': nrm(ks[5], (DEPTH, D_FF, D_MODEL), D_FF ** -0.5),
        'a_w_in': nrm(ks[6], (N_A_LAYERS, D_MODEL, A_IN), D_MODEL ** -0.5),
        'a_q_gain': gain(ks[7], (N_A_LAYERS, HEAD_DIM)),
        'a_k_gain': gain(ks[8], (N_A_LAYERS, HEAD_DIM)),
        'a_w_out': nrm(ks[9], (N_A_LAYERS, A_OUT, D_MODEL), A_OUT ** -0.5),
        'b_w_in': nrm(ks[10], (N_B_LAYERS, D_MODEL, B_IN), D_MODEL ** -0.5),
        'b_q_gain': gain(ks[11], (N_B_LAYERS, HEAD_DIM)),
        'b_k_gain': gain(ks[12], (N_B_LAYERS, HEAD_DIM)),
        'b_w_out': nrm(ks[13], (N_B_LAYERS, B_OUT, D_MODEL), B_OUT ** -0.5),
        'c_w_in': nrm(ks[14], (N_C_LAYERS, D_MODEL, C_IN), D_MODEL ** -0.5),
        'c_conv_w': nrm(ks[15], (N_C_LAYERS, C_CONV, C_CONV_CH), C_CONV ** -0.5),
        'c_a_log': jnp.log(jax.random.uniform(ks[16], (N_C_LAYERS, C_HEADS), jnp.float32, 1.0, 16.0)),
        'c_dt_bias': jnp.log(jnp.expm1(dt)),
        'c_o_gain': gain(ks[17], (N_C_LAYERS, C_VDIM)),
        'c_w_out': nrm(ks[18], (N_C_LAYERS, C_OUT, D_MODEL), C_OUT ** -0.5),
    }


def reference(x, rel_bias, norm_mix, norm_mlp, mlp_w1, mlp_w2,
              a_w_in, a_q_gain, a_k_gain, a_w_out,
              b_w_in, b_q_gain, b_k_gain, b_w_out,
              c_w_in, c_conv_w, c_a_log, c_dt_bias, c_o_gain, c_w_out):
    bias_a = rel_bias[:, :A_BIAS_COLS]
    bias_b = rel_bias[:, A_BIAS_COLS:]
    for i in range(DEPTH):
        kind = i % N_MIXERS
        j = i // N_MIXERS
        h = rms_norm(x, norm_mix[i])
        if kind == 0:
            y = mixer_a(h, a_w_in[j], a_q_gain[j], a_k_gain[j], a_w_out[j], bias_a)
        elif kind == 1:
            y = mixer_b(h, b_w_in[j], b_q_gain[j], b_k_gain[j], b_w_out[j], bias_b)
        else:
            y = mixer_c(h, c_w_in[j], c_conv_w[j], c_a_log[j], c_dt_bias[j], c_o_gain[j], c_w_out[j])
        x = x + y
        x = x + squared_relu_mlp(rms_norm(x, norm_mlp[i]), mlp_w1[i], mlp_w2[i])
    return x
```

```cpp
#include <hip/hip_runtime.h>
#include <hip/hip_cooperative_groups.h>
#include <stdint.h>
#include <cstdio>
namespace cg = cooperative_groups;

typedef unsigned short u16;
typedef __attribute__((ext_vector_type(8))) short bf16x8;
typedef __attribute__((ext_vector_type(4))) short s16x4;
typedef __attribute__((ext_vector_type(16))) float f32x16;
typedef __attribute__((ext_vector_type(4))) float f32x4;
#define DI __device__ __forceinline__
#define MFMA32(a, b, c) __builtin_amdgcn_mfma_f32_32x32x16_bf16((a), (b), (c), 0, 0, 0)
#define MFMA16(a, b, c) __builtin_amdgcn_mfma_f32_16x16x32_bf16((a), (b), (c), 0, 0, 0)

constexpr int NTOK = 32768, DM = 1024, SEQ = 4096;
constexpr size_t MiB = 1ull << 20;
constexpr size_t WS_WT = 0, WS_H = 102 * MiB, WS_P = 166 * MiB, WS_E = 454 * MiB, WS_LSE = 486 * MiB,
                 WS_SIDE = 489 * MiB, WS_STATE = 491 * MiB, WS_HALO = 495 * MiB, WS_GL = 495 * MiB + 512 * 1024,
                 WS_BAR = 495 * MiB + 768 * 1024, WS_END = 496 * MiB;
constexpr size_t WS_CQKV = WS_P, WS_CW = WS_P + 96 * MiB, WS_CU = WS_CW + 32 * MiB, WS_CQ = WS_CU + 32 * MiB,
                 WS_CKT = WS_CQ + 32 * MiB, WS_CQK = WS_CKT + 32 * MiB, WS_CG = WS_CQK + 16 * MiB;
static_assert(WS_CG + 64 * MiB <= WS_LSE, "layer C carve-out");
constexpr size_t WS_SEL = WS_P + 150 * MiB, WS_SELB = WS_P + 170 * MiB, WS_CNT = WS_P + 180 * MiB;
constexpr int HALF_LDS = 76800;
constexpr int LDS_BYTES = 2 * HALF_LDS + 16;

enum { OP_CONVERT = 0, OP_NORM_MIX, OP_GEMM_IN, OP_ATTN_A, OP_COMBINE_A, OP_GEMM_OUT, OP_MIX_B, OP_PREP_C, OP_SCAN_C,
       OP_OUTNORM_C, OP_NORM_MLP, OP_GEMM_W1, OP_GEMM_W2, OP_HEADNORM, OP_SCAN_GEMM };

struct Ctx {
  const float* x; const float* rel_bias; const float* norm_mix; const float* norm_mlp;
  const float* a_q_gain; const float* a_k_gain; const float* b_q_gain; const float* b_k_gain;
  const float* c_conv_w; const float* c_a_log; const float* c_dt_bias; const float* c_o_gain;
  const float* wbase[8];
  float* out; char* ws;
};
struct Params { Ctx c; int ph0; int ph1; unsigned char ops[64]; };

constexpr int cK[16] = {1024, 1024, 512, 512, 1024, 1024, 1024, 1024, 1024, 1024, 1024, 1024, 4096, 4096, 4096, 4096};
constexpr int cN[16] = {4608, 4608, 1024, 1024, 2120, 1024, 4112, 1024, 4096, 4096, 4096, 4096, 1024, 1024, 1024, 1024};
constexpr int cNpad[16] = {4608, 4608, 1024, 1024, 2304, 1024, 4352, 1024, 4096, 4096, 4096, 4096, 1024, 1024, 1024, 1024};
constexpr int cBase[16] = {0, 0, 1, 1, 2, 3, 4, 5, 6, 6, 6, 6, 7, 7, 7, 7};
constexpr unsigned cSrcOff[16] = {0, 1024u * 4608u, 0, 512u * 1024u, 0, 0, 0, 0, 0, 4194304u, 2u * 4194304u, 3u * 4194304u, 0, 4194304u, 2u * 4194304u, 3u * 4194304u};
constexpr unsigned wOff(int i) { unsigned o = 0; for (int k = 0; k < i; ++k) o += (unsigned)cK[k] * (unsigned)cNpad[k]; return o; }
constexpr int wTileStart(int i) { int o = 0; for (int k = 0; k < i; ++k) o += (cK[k] / 64) * (cNpad[k] / 64); return o; }
static_assert((size_t)wOff(16) * 2 <= 102 * MiB, "WT region");

template <class T> DI T* lau(T* x) { asm volatile("" : "+s"(x)); return x; }
template <class T> DI T* lauv(T* x) { asm volatile("" : "+v"(x)); return x; }
DI int tidx(int wv) {
  int w = wv;
  asm volatile("" : "+s"(w));
  int l = (int)__builtin_amdgcn_mbcnt_hi(~0u, __builtin_amdgcn_mbcnt_lo(~0u, 0u));
  asm volatile("" : "+v"(l));
  return (w << 6) | l;
}
DI int lane_now() { int l = (int)__builtin_amdgcn_mbcnt_hi(~0u, __builtin_amdgcn_mbcnt_lo(~0u, 0u)); asm volatile("" : "+v"(l)); return l; }
DI float shx(float v, int m) { return __int_as_float(__builtin_amdgcn_ds_bpermute((lane_now() ^ m) << 2, __float_as_int(v))); }
DI int shx(int v, int m) { return __builtin_amdgcn_ds_bpermute((lane_now() ^ m) << 2, v); }
DI float shidx(float v, int src) { return __int_as_float(__builtin_amdgcn_ds_bpermute(src << 2, __float_as_int(v))); }
DI int shidx(int v, int src) { return __builtin_amdgcn_ds_bpermute(src << 2, v); }
DI int shdown(int v, int d) { const int l = lane_now(); return __builtin_amdgcn_ds_bpermute((l + d < 64 ? l + d : l) << 2, v); }
DI float shup(float v, int d) { const int l = lane_now(); return __int_as_float(__builtin_amdgcn_ds_bpermute((l - d >= 0 ? l - d : l) << 2, __float_as_int(v))); }
typedef float f32x2_t __attribute__((ext_vector_type(2)));
typedef __bf16 bf16x2_t __attribute__((ext_vector_type(2)));
DI unsigned pk2bf(float lo, float hi) { const f32x2_t v = {lo, hi}; return __builtin_bit_cast(unsigned, __builtin_convertvector(v, bf16x2_t)); }
DI u16 f2bf(float x) { return (u16)(pk2bf(x, 0.f) & 0xffffu); }
DI float bf2f(u16 v) { return __uint_as_float(((unsigned)v) << 16); }
DI float bfs(short v) { return __uint_as_float(((unsigned)(u16)v) << 16); }
DI int crow(int i, int h) { return (i & 3) + 8 * (i >> 2) + 4 * h; }
DI int kpos(int d) { int e = d & 15; return (d & ~15) + ((e >> 2) & 1) * 8 + (e >> 3) * 4 + (e & 3); }
DI bf16x8 pack8(const f32x16& x, int s) {
  typedef unsigned u32x4_t __attribute__((ext_vector_type(4)));
  u32x4_t r;
  r[0] = pk2bf(x[8 * s + 0], x[8 * s + 1]); r[1] = pk2bf(x[8 * s + 2], x[8 * s + 3]);
  r[2] = pk2bf(x[8 * s + 4], x[8 * s + 5]); r[3] = pk2bf(x[8 * s + 6], x[8 * s + 7]);
  return __builtin_bit_cast(bf16x8, r);
}
DI f32x16 zero16() { f32x16 z;
#pragma unroll
  for (int i = 0; i < 16; ++i) z[i] = 0.f; return z; }
DI bf16x8 zero8() { int zz = 0; asm volatile("" : "+v"(zz)); bf16x8 z;
#pragma unroll
  for (int i = 0; i < 8; ++i) z[i] = (short)zz; return z; }
DI int t5_bucket(int dist) {
  if (dist < 16) return dist;
  float lp = logf((float)dist / 16.0f) / 4.852030263919617f * 16.0f;
  int b = 16 + (int)lp;
  return b < 31 ? b : 31;
}

namespace pg8 {
#define PG8_LAS __attribute__((address_space(3)))
typedef unsigned short bf16_t;
typedef short bf16x8 __attribute__((ext_vector_type(8)));
typedef float f32x4 __attribute__((ext_vector_type(4)));
typedef unsigned u32x4 __attribute__((ext_vector_type(4)));
constexpr int BM = 256, BK = 64, HALF = 128, HTB = HALF * BK * 2  , STAGE_BYTES = 8 * HTB, NXCD = 8, WGM = 8;

__host__ __device__ __forceinline__ int lds_byte(int r, int c) { const int st = (r >> 4) * 2 + (c >> 5), rr = r & 15, cc = c & 31, ob = rr * 64 + cc * 2; return st * 1024 + (ob ^ (((ob >> 9) & 1) << 5)); }
__host__ __device__ __forceinline__ void stage_rc(int b, int& R, int& C) { const int st = b / 1024, sb = b % 1024, swz = sb ^ (((sb >> 9) & 1) << 5); R = (st >> 1) * 16 + swz / 64; C = (st & 1) * 32 + (swz % 64) / 2; }
__host__ __device__ __forceinline__ int perm32(int rho) { const int n = rho >> 4, i = rho & 15; return 8 * (i >> 2) + 4 * n + (i & 3); }

struct Unit { int pm, pn; };
struct Gemm { const bf16_t* A; const bf16_t* Bt; int M, N, K; int half; };
__device__ __forceinline__ size_t a_tile_row(const Gemm& g, int pm) { return g.half < 0 ? (size_t)pm * 256 : (size_t)(pm >> 3) * 4096 + (size_t)g.half * 2048 + (size_t)(pm & 7) * 256; }

struct StaticOrder {
    int nM, nN, nwg, G, c;
    __host__ __device__ void init(int M, int N, int G_, int c_) { nM = M / BM; nN = N / BM; nwg = nM * nN; G = G_; c = c_; }
    __host__ __device__ bool next(int i, Unit& u) const {
        const long L = (long)i * G + c; if (L >= nwg) return false;
        int wgid = (int)L; { const int q = nwg / NXCD, r = nwg % NXCD, xcd = wgid % NXCD, off = wgid / NXCD; wgid = (xcd < r ? xcd * (q + 1) : r * (q + 1) + (xcd - r) * q) + off; }
        const int nig = WGM * nN, gid = wgid / nig, fm = gid * WGM, gsz = (nM - fm) < WGM ? (nM - fm) : WGM;
        u.pm = fm + ((wgid % nig) % gsz); u.pn = (wgid % nig) / gsz; return true;
    }
    __device__ __forceinline__ void a_ready(const Unit&) const {}
    __device__ __forceinline__ void done(const Unit&) const {}
};
__device__ __forceinline__ unsigned cvt_pk_bf16(float lo, float hi) { unsigned r; asm volatile("v_cvt_pk_bf16_f32 %0, %1, %2" : "=v"(r) : "v"(lo), "v"(hi)); return r; }
template <class Epi, class Sched>
__device__ __forceinline__ void gemm_phase(PG8_LAS unsigned char* lds, const Gemm g, const Sched& S, const Epi& E, const int tid) {
    const int wid = __builtin_amdgcn_readfirstlane(tid >> 6), lane = tid & 63, wr = wid >> 2, wc = wid & 3, fr = lane & 15, fq = lane >> 4;
    const int K = g.K, nt = K / BK;
    unsigned voffA[2], voffB[2];
#pragma unroll
    for (int i = 0; i < 2; ++i) { int R, C; stage_rc(tid * 16 + i * 8192, R, C); const int Rb = Epi::PERM ? ((R & ~31) + perm32(R & 31)) : R;
        voffA[i] = (unsigned)(R * K + C) * 2u; voffB[i] = (unsigned)(Rb * K + C) * 2u; }
    const size_t kstep = (size_t)(BK * 2);
    const size_t hstep = (size_t)HALF * K * 2;
    const size_t tstep = 2 * hstep;
    const unsigned ldsw = (unsigned)wid * 1024u;
    const int aoff = lds_byte(wr * 64 + fr, fq * 8), boff = lds_byte(wc * 32 + fr, fq * 8);
#define PG8_SA(b, h) (((b) * 2 + (h)) * HTB)
#define PG8_SB(b, h) ((4 + (b) * 2 + (h)) * HTB)
#define PG8_STAGE(bufoff, gbase, voff) do { _Pragma("unroll") for (int _i = 0; _i < 2; ++_i) \
        __builtin_amdgcn_global_load_lds((const unsigned*)((const char*)(gbase) + (voff)[_i]), (PG8_LAS unsigned*)(lds + (bufoff) + ldsw + _i * 8192), 16, 0, 0); } while (0)
#define PG8_LDA(dst, b, h) do { _Pragma("unroll") for (int m = 0; m < 4; ++m) _Pragma("unroll") for (int k = 0; k < 2; ++k) dst[m][k] = *(const PG8_LAS bf16x8*)(lds + PG8_SA(b, h) + aoff + m * 2048 + k * 1024); } while (0)
#define PG8_LDB(dst, b, h) do { _Pragma("unroll") for (int n = 0; n < 2; ++n) _Pragma("unroll") for (int k = 0; k < 2; ++k) dst[n][k] = *(const PG8_LAS bf16x8*)(lds + PG8_SB(b, h) + boff + n * 2048 + k * 1024); } while (0)
#define PG8_MMA(ai, bj, At, Bt) do { __builtin_amdgcn_s_setprio(1); _Pragma("unroll") for (int m = 0; m < 4; ++m) _Pragma("unroll") for (int n = 0; n < 2; ++n) _Pragma("unroll") for (int k = 0; k < 2; ++k) \
        acc[ai][bj][m][n] = __builtin_amdgcn_mfma_f32_16x16x32_bf16(Bt[n][k], At[m][k], acc[ai][bj][m][n], 0, 0, 0); __builtin_amdgcn_s_setprio(0); } while (0)
#define PG8_WAIT_V(n) asm volatile("s_waitcnt vmcnt(" #n ")" ::: "memory")
#define PG8_WAIT_L(n) asm volatile("s_waitcnt lgkmcnt(" #n ")" ::: "memory")
#define PG8_BAR __builtin_amdgcn_s_barrier()
#define PG8_SCHED __builtin_amdgcn_sched_barrier(0)
    Unit cur, nxt; int ui = 0;
    if (!S.next(0, cur)) return;
    f32x4 acc[2][2][4][2];
#pragma unroll
    for (int a = 0; a < 2; ++a)
#pragma unroll
        for (int b = 0; b < 2; ++b)
#pragma unroll
            for (int m = 0; m < 4; ++m)
#pragma unroll
                for (int n = 0; n < 2; ++n) acc[a][b][m][n] = (f32x4){0.f, 0.f, 0.f, 0.f};
    bf16x8 At[4][2], B0[2][2], B1[2][2];
    const char* cA = (const char*)g.A + a_tile_row(g, cur.pm) * (size_t)K * 2; const char* cB = (const char*)g.Bt + (size_t)cur.pn * tstep;
    S.a_ready(cur);
    PG8_STAGE(PG8_SB(0, 0), cB, voffB); PG8_STAGE(PG8_SA(0, 0), cA, voffA); PG8_STAGE(PG8_SB(0, 1), cB + hstep, voffB); PG8_STAGE(PG8_SA(0, 1), cA + hstep, voffA);
    if (wr == 1) PG8_BAR;
    PG8_WAIT_V(4); PG8_BAR;
    PG8_STAGE(PG8_SB(1, 0), cB + kstep, voffB); PG8_STAGE(PG8_SA(1, 0), cA + kstep, voffA); PG8_STAGE(PG8_SB(1, 1), cB + hstep + kstep, voffB);
    PG8_WAIT_V(6); PG8_BAR;
    for (;;) {
        const bool has_next = S.next(ui + 1, nxt);
        const char* nA = has_next ? (const char*)g.A + a_tile_row(g, nxt.pm) * (size_t)K * 2 : cA; const char* nB = has_next ? (const char*)g.Bt + (size_t)nxt.pn * tstep : cB;
        for (int t = 0; t < nt; t += 2) {
            const bool last = (t == nt - 2);
            const char* a1 = cA + (size_t)(t + 1) * kstep;
            const char* a2 = last ? nA : cA + (size_t)(t + 2) * kstep; const char* b2 = last ? nB : cB + (size_t)(t + 2) * kstep;
            const char* a3 = a2 + kstep; const char* b3 = b2 + kstep;
            if (last && has_next) S.a_ready(nxt);
            PG8_LDB(B0, 0, 0); PG8_SCHED; PG8_LDA(At, 0, 0); PG8_STAGE(PG8_SA(1, 1), a1 + hstep, voffA);
            PG8_WAIT_L(8); PG8_BAR; PG8_WAIT_L(0); PG8_MMA(0, 0, At, B0); PG8_BAR; PG8_SCHED;
            PG8_LDB(B1, 0, 1); PG8_STAGE(PG8_SB(0, 0), b2, voffB);
            PG8_BAR; PG8_WAIT_L(0); PG8_MMA(0, 1, At, B1); PG8_BAR;
            PG8_LDA(At, 0, 1); PG8_STAGE(PG8_SA(0, 0), a2, voffA);
            PG8_BAR; PG8_WAIT_L(0); PG8_MMA(1, 0, At, B0); PG8_BAR; PG8_SCHED;
            PG8_STAGE(PG8_SB(0, 1), b2 + hstep, voffB);
            PG8_WAIT_V(6); PG8_BAR; PG8_MMA(1, 1, At, B1); PG8_BAR;
            PG8_LDB(B0, 1, 0); PG8_SCHED; PG8_LDA(At, 1, 0); PG8_STAGE(PG8_SA(0, 1), a2 + hstep, voffA);
            PG8_WAIT_L(8); PG8_BAR; PG8_WAIT_L(0); PG8_MMA(0, 0, At, B0); PG8_BAR; PG8_SCHED;
            PG8_LDB(B1, 1, 1); PG8_STAGE(PG8_SB(1, 0), b3, voffB);
            PG8_BAR; PG8_WAIT_L(0); PG8_MMA(0, 1, At, B1); PG8_BAR;
            PG8_LDA(At, 1, 1); PG8_STAGE(PG8_SA(1, 0), a3, voffA);
            PG8_BAR; PG8_WAIT_L(0); PG8_MMA(1, 0, At, B0); PG8_BAR; PG8_SCHED;
            PG8_STAGE(PG8_SB(1, 1), b3 + hstep, voffB);
            PG8_WAIT_V(6); PG8_BAR; PG8_MMA(1, 1, At, B1); PG8_BAR;
        }
        if constexpr (!Epi::AFTER_DRAIN) { E(acc, cur, wr, wc, fr, fq); S.done(cur); }
        if (!has_next) break;
#pragma unroll
        for (int a = 0; a < 2; ++a)
#pragma unroll
            for (int b = 0; b < 2; ++b)
#pragma unroll
                for (int m = 0; m < 4; ++m)
#pragma unroll
                    for (int n = 0; n < 2; ++n) acc[a][b][m][n] = (f32x4){0.f, 0.f, 0.f, 0.f};
        cur = nxt; cA = nA; cB = nB; ++ui;
    }
    PG8_WAIT_V(0);
    if (wr == 0) PG8_BAR;
    PG8_BAR;
    if constexpr (Epi::AFTER_DRAIN) { E.fused(acc, cur, wr, wc, fr, fq, lds, wid, lane); S.done(cur); }
#undef PG8_SA
#undef PG8_SB
#undef PG8_STAGE
#undef PG8_LDA
#undef PG8_LDB
#undef PG8_MMA
#undef PG8_WAIT_V
#undef PG8_WAIT_L
#undef PG8_BAR
#undef PG8_SCHED
}
}


namespace pg8 {
template <int ACT> struct EpiB16 {
    static constexpr bool PERM = true, AFTER_DRAIN = false;
    bf16_t* O; int ldc;
    __device__ __forceinline__ void operator()(const f32x4 (&acc)[2][2][4][2], const Unit& u, int wr, int wc, int fr, int fq) const {
        const int row0 = u.pm * BM + wr * 64 + fr, col0 = u.pn * BM + wc * 32 + 8 * fq;
#pragma unroll
        for (int ai = 0; ai < 2; ++ai)
#pragma unroll
            for (int m = 0; m < 4; ++m) { bf16_t* rowp = O + (size_t)(row0 + ai * HALF + m * 16) * ldc + col0;
#pragma unroll
                for (int bj = 0; bj < 2; ++bj) { f32x4 v0 = acc[ai][bj][m][0], v1 = acc[ai][bj][m][1];
                    if (ACT == 1) {
#pragma unroll
                        for (int j = 0; j < 4; ++j) { float a = v0[j] > 0.f ? v0[j] : 0.f, b = v1[j] > 0.f ? v1[j] : 0.f; v0[j] = a * a; v1[j] = b * b; } }
                    u32x4 w; w.x = cvt_pk_bf16(v0[0], v0[1]); w.y = cvt_pk_bf16(v0[2], v0[3]); w.z = cvt_pk_bf16(v1[0], v1[1]); w.w = cvt_pk_bf16(v1[2], v1[3]);
                    *(u32x4*)(rowp + bj * HALF) = w; } }
    }
};
struct EpiB16HN {
    static constexpr bool PERM = true, AFTER_DRAIN = false;
    bf16_t* O; int ldc; int ncols_norm, nq_cols; const float* gq; const float* gk; PG8_LAS float* T;
    __device__ __forceinline__ void operator()(const f32x4 (&acc)[2][2][4][2], const Unit& u, int wr, int wc, int fr, int fq) const {
        const int row0 = u.pm * BM + wr * 64 + fr, col0 = u.pn * BM + wc * 32 + 8 * fq;
        const bool hn = u.pn * BM < ncols_norm;
        float part[2][4][2];
        if (hn) {
#pragma unroll
            for (int ai = 0; ai < 2; ++ai)
#pragma unroll
                for (int m = 0; m < 4; ++m)
#pragma unroll
                    for (int bj = 0; bj < 2; ++bj) { const f32x4 a = acc[ai][bj][m][0], b = acc[ai][bj][m][1];
                        float sq = a[0] * a[0] + a[1] * a[1] + a[2] * a[2] + a[3] * a[3] + b[0] * b[0] + b[1] * b[1] + b[2] * b[2] + b[3] * b[3];
                        sq += shx(sq, 16); sq += shx(sq, 32); part[ai][m][bj] = sq; }
            PG8_LAS float* mine = T + ((wr * 4 + wc) * 16) * 16 + fr;
            if (fq == 0) {
#pragma unroll
                for (int ai = 0; ai < 2; ++ai)
#pragma unroll
                    for (int m = 0; m < 4; ++m)
#pragma unroll
                        for (int bj = 0; bj < 2; ++bj) mine[((ai * 4 + m) * 2 + bj) * 16] = part[ai][m][bj];
            }
            asm volatile("s_waitcnt lgkmcnt(0)" ::: "memory");
            __builtin_amdgcn_s_barrier();
            const PG8_LAS float* other = T + ((wr * 4 + (wc ^ 1)) * 16) * 16 + fr;
#pragma unroll
            for (int ai = 0; ai < 2; ++ai)
#pragma unroll
                for (int m = 0; m < 4; ++m)
#pragma unroll
                    for (int bj = 0; bj < 2; ++bj) part[ai][m][bj] += other[((ai * 4 + m) * 2 + bj) * 16];
        }
        const bool isq = u.pn * BM < nq_cols;
        const float* gp = (isq ? gq : gk) + ((wc & 1) * 32 + 8 * fq);
        const float qs = isq ? 0.125f : 1.0f;
        float g8[8];
#pragma unroll
        for (int j = 0; j < 8; ++j) g8[j] = hn ? gp[j] * qs : 1.0f;
#pragma unroll
        for (int ai = 0; ai < 2; ++ai)
#pragma unroll
            for (int m = 0; m < 4; ++m) { bf16_t* rowp = O + (size_t)(row0 + ai * HALF + m * 16) * ldc + col0;
#pragma unroll
                for (int bj = 0; bj < 2; ++bj) { f32x4 v0 = acc[ai][bj][m][0], v1 = acc[ai][bj][m][1];
                    const float r = hn ? rsqrtf(part[ai][m][bj] * (1.0f / 64.0f) + 1e-6f) : 1.0f;
#pragma unroll
                    for (int j = 0; j < 4; ++j) { v0[j] *= r * g8[j]; v1[j] *= r * g8[4 + j]; }
                    u32x4 w; w.x = cvt_pk_bf16(v0[0], v0[1]); w.y = cvt_pk_bf16(v0[2], v0[3]); w.z = cvt_pk_bf16(v1[0], v1[1]); w.w = cvt_pk_bf16(v1[2], v1[3]);
                    *(u32x4*)(rowp + bj * HALF) = w; } }
    }
};
struct EpiResid {
    static constexpr bool PERM = false, AFTER_DRAIN = false;
    float* C; const float* X;
    __device__ __forceinline__ void operator()(const f32x4 (&acc)[2][2][4][2], const Unit& u, int wr, int wc, int fr, int fq) const {
        const int row0 = u.pm * BM + wr * 64 + fr, col0 = u.pn * BM + wc * 32 + 4 * fq;
#pragma unroll
        for (int ai = 0; ai < 2; ++ai) {
            f32x4 xv[4][2][2];
#pragma unroll
            for (int m = 0; m < 4; ++m)
#pragma unroll
                for (int bj = 0; bj < 2; ++bj)
#pragma unroll
                    for (int n = 0; n < 2; ++n) xv[m][bj][n] = *(const f32x4*)(X + (size_t)(row0 + ai * HALF + m * 16) * 1024 + col0 + bj * HALF + n * 16);
#pragma unroll
            for (int m = 0; m < 4; ++m)
#pragma unroll
                for (int bj = 0; bj < 2; ++bj)
#pragma unroll
                    for (int n = 0; n < 2; ++n) *(f32x4*)(C + (size_t)(row0 + ai * HALF + m * 16) * 1024 + col0 + bj * HALF + n * 16) = xv[m][bj][n] + acc[ai][bj][m][n];
        }
    }
};
struct EpiCIn {
    static constexpr bool PERM = true, AFTER_DRAIN = false;
    bf16_t* Q; bf16_t* G; float* S; int half;
    __device__ __forceinline__ void operator()(const f32x4 (&acc)[2][2][4][2], const Unit& u, int wr, int wc, int fr, int fq) const {
        const int rl0 = wr * 64 + fr, cl0 = wc * 32 + 8 * fq;
        const size_t crow0 = (size_t)u.pm * 256, arow0 = (size_t)(u.pm >> 3) * 4096 + (size_t)half * 2048 + (size_t)(u.pm & 7) * 256;
#pragma unroll
        for (int ai = 0; ai < 2; ++ai)
#pragma unroll
            for (int m = 0; m < 4; ++m) { const int rl = rl0 + ai * HALF + m * 16;
#pragma unroll
                for (int bj = 0; bj < 2; ++bj) { const f32x4 v0 = acc[ai][bj][m][0], v1 = acc[ai][bj][m][1]; const int cl = cl0 + bj * HALF;
                    if (u.pn < 16) {
                        u32x4 w; w.x = cvt_pk_bf16(v0[0], v0[1]); w.y = cvt_pk_bf16(v0[2], v0[3]); w.z = cvt_pk_bf16(v1[0], v1[1]); w.w = cvt_pk_bf16(v1[2], v1[3]);
                        if (u.pn < 12) *(u32x4*)(Q + (crow0 + rl) * 3072 + u.pn * 256 + cl) = w;
                        else *(u32x4*)(G + (arow0 + rl) * 1024 + (u.pn - 12) * 256 + cl) = w;
                    } else if (cl < 16) { float* sp = S + (arow0 + rl) * 16 + cl; *(f32x4*)sp = v0; *(f32x4*)(sp + 4) = v1; } } }
    }
};
}

struct CvtTile { const float* src; int K, N, k0, n0; unsigned off; };
DI CvtTile cvt_locate(const Ctx& p, int t) {
  int K = cK[0], N = cN[0], base = 0; unsigned off = 0, soff = 0; int bi = 0;
#define WSEL(i) if (t >= wTileStart(i)) { K = cK[i]; N = cN[i]; base = wTileStart(i); off = wOff(i); soff = cSrcOff[i]; bi = cBase[i]; }
  WSEL(1) WSEL(2) WSEL(3) WSEL(4) WSEL(5) WSEL(6) WSEL(7) WSEL(8) WSEL(9) WSEL(10) WSEL(11) WSEL(12) WSEL(13) WSEL(14) WSEL(15)
#undef WSEL
  const float* src = p.wbase[0];
#pragma unroll
  for (int q = 1; q < 8; ++q) if (bi == q) src = p.wbase[q];
  const int lt = t - base, nkt = K / 64;
  CvtTile c; c.src = src + soff; c.K = K; c.N = N; c.k0 = (lt % nkt) * 64; c.n0 = (lt / nkt) * 64; c.off = off;
  return c;
}
DI void phase_convert(int wv_, int vb_, int nvb_, char* ws_, const Ctx& p, char* smem) {
  float* tile = (float*)smem;
  const int tid = tidx(wv_);
  const int ty = tid >> 4, tx = tid & 15;
  constexpr int total = wTileStart(16);
  const int trips_ = (total + nvb_ - 1) / nvb_;
#define CVT_LOAD(C, V) { _Pragma("unroll") for (int i = 0; i < 4; ++i) { const int n_ = (C).n0 + tx * 4; \
    V[i] = (n_ < (C).N) ? *(const float4*)((C).src + (size_t)((C).k0 + ty + 16 * i) * (C).N + n_) : make_float4(0.f, 0.f, 0.f, 0.f); } }
  CvtTile cur = cvt_locate(p, (vb_ < total) ? vb_ : total - 1);
  float4 v[4];
  CVT_LOAD(cur, v)
  for (int k_ = 0; k_ < trips_; ++k_) {
    const int tn = vb_ + (k_ + 1) * nvb_;
    const CvtTile nxt = cvt_locate(p, (tn < total) ? tn : total - 1);
    float4 vn[4];
    CVT_LOAD(nxt, vn)
#pragma unroll
    for (int i = 0; i < 4; ++i) { float* d = tile + (ty + 16 * i) * 65 + tx * 4; d[0] = v[i].x; d[1] = v[i].y; d[2] = v[i].z; d[3] = v[i].w; }
    __syncthreads();
    {
      const int n = tid >> 2, kq = tid & 3;
      bf16x8 o0, o1;
#pragma unroll
      for (int j = 0; j < 8; ++j) { o0[j] = (short)f2bf(tile[(kq * 16 + j) * 65 + n]); o1[j] = (short)f2bf(tile[(kq * 16 + 8 + j) * 65 + n]); }
      u16* dst = (u16*)(ws_ + WS_WT) + (size_t)cur.off + (size_t)(cur.n0 + n) * cur.K + cur.k0 + kq * 16;
      *(bf16x8*)dst = o0; *(bf16x8*)(dst + 8) = o1;
    }
    __syncthreads();
    cur = nxt;
#pragma unroll
    for (int i = 0; i < 4; ++i) v[i] = vn[i];
  }
#undef CVT_LOAD
}

DI void phase_norm(int wv_, int vb_, int nvb_, const float* x, const float* gain, u16* H) {
  const int tid = tidx(wv_); const int lane = tid & 63, wave = tid >> 6;
  float4 g[4];
#pragma unroll
  for (int c = 0; c < 4; ++c) g[c] = ((const float4*)gain)[c * 64 + lane];
  for (int row0 = (vb_ * 4 + wave) * 4; row0 < NTOK; row0 += nvb_ * 16) {
    float4 v[4][4]; float ss[4];
#pragma unroll
    for (int r = 0; r < 4; ++r) {
      const float4* xr = (const float4*)(x + (size_t)(row0 + r) * DM);
#pragma unroll
      for (int c = 0; c < 4; ++c) v[r][c] = xr[c * 64 + lane];
    }
#pragma unroll
    for (int r = 0; r < 4; ++r) { float a = 0.f;
#pragma unroll
      for (int c = 0; c < 4; ++c) a += v[r][c].x * v[r][c].x + v[r][c].y * v[r][c].y + v[r][c].z * v[r][c].z + v[r][c].w * v[r][c].w;
      ss[r] = a; }
#pragma unroll
    for (int o = 1; o < 64; o <<= 1) {
#pragma unroll
      for (int r = 0; r < 4; ++r) ss[r] += shx(ss[r], o);
    }
#pragma unroll
    for (int r = 0; r < 4; ++r) {
      const float rr = rsqrtf(ss[r] * (1.0f / DM) + 1e-6f);
#pragma unroll
      for (int c = 0; c < 4; ++c) {
        s16x4 o; o[0] = (short)f2bf(v[r][c].x * rr * g[c].x); o[1] = (short)f2bf(v[r][c].y * rr * g[c].y); o[2] = (short)f2bf(v[r][c].z * rr * g[c].z); o[3] = (short)f2bf(v[r][c].w * rr * g[c].w);
        *(s16x4*)(H + (size_t)(row0 + r) * DM + (c * 64 + lane) * 4) = o;
      }
    }
  }
}

DI void phase_headnorm(int wv_, int vb_, int nvb_, u16* P, int ld, int nheads, int nq, const float* gq, const float* gk) {
  const int tid = tidx(wv_);
  const int part = tid & 7;
  const size_t total = (size_t)NTOK * nheads * 8;
  for (size_t idx = (size_t)vb_ * 256 + tid; idx < total; idx += (size_t)nvb_ * 256) {
    const size_t rh = idx >> 3; const size_t row = rh / nheads; const int head = (int)(rh - row * nheads);
    u16* pp = P + row * ld + head * 64 + part * 8;
    bf16x8 v = *(const bf16x8*)pp;
    float f[8]; float ss = 0.f;
#pragma unroll
    for (int j = 0; j < 8; ++j) { f[j] = bfs(v[j]); ss += f[j] * f[j]; }
    ss += shx(ss, 1); ss += shx(ss, 2); ss += shx(ss, 4);
    const float rn = rsqrtf(ss * (1.0f / 64.0f) + 1e-6f) * (head < nq ? 0.125f : 1.0f);
    const float* g = (head < nq ? gq : gk) + part * 8;
    bf16x8 o;
#pragma unroll
    for (int j = 0; j < 8; ++j) o[j] = (short)f2bf(f[j] * rn * g[j]);
    *(bf16x8*)pp = o;
  }
}

DI void phase_attn_a(int wv_, int vb_, int nvb_, char* ws_, const Ctx& p, char* smem) {
  u16* Vt = (u16*)smem;
  float* sBias = (float*)(smem + 64 * 260 * 2);
  const u16* P = (const u16*)(ws_ + WS_P);
  const int tid = tidx(wv_), lane = tid & 63, wave = tid >> 6, c = lane & 31, h = lane >> 5;
  for (int k_ = 0; k_ < (6144 + nvb_ - 1) / nvb_; ++k_) {
    const int u = (vb_ + k_ * nvb_ < 6144) ? vb_ + k_ * nvb_ : 6143;
    const int head = u & 7, g = (u >> 3) % 3, rest = u / 24, idx = rest & 31, b = rest >> 5;
    const int dil = (g == 0) ? 1 : ((g == 1) ? 4 : 16);
    const int nbper = 32 / dil, r = idx / nbper, nb = idx % nbper;
    u16* Og = (g == 0) ? (u16*)(ws_ + WS_H) : ((g == 1) ? (u16*)(ws_ + WS_H + 32 * MiB) : (u16*)(ws_ + WS_E));
    float* lse = (float*)(ws_ + WS_LSE) + (size_t)g * NTOK * 8;
    if (tid <= 128) sBias[tid] = p.rel_bias[t5_bucket(tid * dil) * 40 + g * 8 + head];
    {
      const int kk = tid; const int ksub = nb * 128 - 128 + kk;
      bf16x8 v[8];
      if (ksub >= 0) {
        const u16* vp = P + ((size_t)b * SEQ + (size_t)ksub * dil + r) * 4608 + 3072 + g * 512 + head * 64;
#pragma unroll
        for (int i = 0; i < 8; ++i) v[i] = *(const bf16x8*)(vp + i * 8);
      } else {
#pragma unroll
        for (int i = 0; i < 8; ++i) v[i] = zero8();
      }
#pragma unroll
      for (int i = 0; i < 8; ++i)
#pragma unroll
        for (int jj = 0; jj < 8; ++jj) Vt[(i * 8 + jj) * 260 + kk] = (u16)v[i][jj];
    }
    __syncthreads();
    {
      const int qi = 32 * wave + c;
      const int qtok = (nb * 128 + qi) * dil + r;
      const u16* qp = P + ((size_t)b * SEQ + qtok) * 4608 + g * 512 + head * 64;
      bf16x8 qf[4];
#pragma unroll
      for (int ks = 0; ks < 4; ++ks) qf[ks] = *(const bf16x8*)(qp + ks * 16 + h * 8);
      float mx = -INFINITY, sum = 0.f;
      f32x16 oacc[2]; oacc[0] = zero16(); oacc[1] = zero16();
#pragma unroll 1
      for (int kb = 0; kb < 5; ++kb) {
        const int kk = 32 * wave + 32 * kb + c; const int ksub0 = nb * 128 - 128 + kk;
        bf16x8 kf[4];
        if (ksub0 >= 0) {
          const u16* kp = P + ((size_t)b * SEQ + (size_t)ksub0 * dil + r) * 4608 + 1536 + g * 512 + head * 64;
#pragma unroll
          for (int ks = 0; ks < 4; ++ks) kf[ks] = *(const bf16x8*)(kp + ks * 16 + h * 8);
        } else {
#pragma unroll
          for (int ks = 0; ks < 4; ++ks) kf[ks] = zero8();
        }
        f32x16 sa = zero16();
#pragma unroll
        for (int ks = 0; ks < 4; ++ks) sa = MFMA32(kf[ks], qf[ks], sa);
        float bm = -INFINITY;
        const int sbase = c + 128 - 32 * kb - 4 * h;
        const unsigned slim = (unsigned)((nb * 128 + 32 * wave + c) < 128 ? (nb * 128 + 32 * wave + c) : 128);
#pragma unroll
        for (int i = 0; i < 16; ++i) {
          const int step = sbase - ((i & 3) + 8 * (i >> 2));
          const bool valid = (unsigned)step <= slim;
          const float bv = sBias[step];
          float v = valid ? sa[i] + bv : -INFINITY;
          sa[i] = v; bm = fmaxf(bm, v);
        }
        bm = fmaxf(bm, shx(bm, 32));
        const float mnew = fmaxf(mx, bm);
        const float mref = (mnew == -INFINITY) ? 0.f : mnew;
        const float scale = __expf(mx - mref);
        float ps = 0.f;
#pragma unroll
        for (int i = 0; i < 16; ++i) { float pv = __expf(sa[i] - mref); sa[i] = pv; ps += pv; }
        sum = sum * scale + ps; mx = mnew;
#pragma unroll
        for (int i = 0; i < 16; ++i) { oacc[0][i] *= scale; oacc[1][i] *= scale; }
#pragma unroll
        for (int s = 0; s < 2; ++s) {
          bf16x8 pb = pack8(sa, s);
          const int keybase = 32 * wave + 32 * kb + 16 * s;
#pragma unroll
          for (int mb = 0; mb < 2; ++mb) {
            const u16* vr = Vt + (mb * 32 + c) * 260 + keybase + 4 * h;
            s16x4 lo = *(const s16x4*)vr, hi = *(const s16x4*)(vr + 8);
            bf16x8 va = __builtin_shufflevector(lo, hi, 0, 1, 2, 3, 4, 5, 6, 7);
            oacc[mb] = MFMA32(va, pb, oacc[mb]);
          }
        }
      }
      sum += shx(sum, 32);
      const float inv = 1.0f / sum;
      u16* op = Og + ((size_t)b * SEQ + qtok) * 512 + head * 64;
#pragma unroll
      for (int mb = 0; mb < 2; ++mb)
#pragma unroll
        for (int ig = 0; ig < 4; ++ig) {
          s16x4 o;
#pragma unroll
          for (int q = 0; q < 4; ++q) o[q] = (short)f2bf(oacc[mb][ig * 4 + q] * inv);
          *(s16x4*)(op + mb * 32 + 8 * ig + 4 * h) = o;
        }
      if (h == 0) lse[((size_t)b * SEQ + qtok) * 8 + head] = mx + logf(sum);
    }
    __syncthreads();
  }
}

DI void phase_combine_a(int wv_, int vb_, int nvb_, char* ws_, const Ctx& p) {
  u16* O0 = (u16*)(ws_ + WS_H); const u16* O1 = (const u16*)(ws_ + WS_H + 32 * MiB); const u16* O2 = (const u16*)(ws_ + WS_E);
  const float* lse = (const float*)(ws_ + WS_LSE);
  const int tid = tidx(wv_);
  const size_t stride = (size_t)nvb_ * 256, total = (size_t)NTOK * 64;
  for (size_t idx0 = (size_t)vb_ * 256 + tid; idx0 < total; idx0 += 4 * stride) {
    bf16x8 a[4], b[4], cc[4]; float l0[4], l1[4], l2[4]; bool ok[4];
#pragma unroll
    for (int q = 0; q < 4; ++q) {
      const size_t idx = idx0 + q * stride; ok[q] = idx < total; const size_t ix = ok[q] ? idx : idx0;
      const size_t tok = ix >> 6; const int head = (ix >> 3) & 7;
      l0[q] = lse[tok * 8 + head]; l1[q] = lse[(size_t)NTOK * 8 + tok * 8 + head]; l2[q] = lse[(size_t)2 * NTOK * 8 + tok * 8 + head];
      a[q] = *(const bf16x8*)(O0 + ix * 8); b[q] = *(const bf16x8*)(O1 + ix * 8); cc[q] = *(const bf16x8*)(O2 + ix * 8);
    }
#pragma unroll
    for (int q = 0; q < 4; ++q) {
      const float m = fmaxf(l0[q], fmaxf(l1[q], l2[q]));
      float e0 = __expf(l0[q] - m), e1 = __expf(l1[q] - m), e2 = __expf(l2[q] - m);
      const float inv = 1.0f / (e0 + e1 + e2); e0 *= inv; e1 *= inv; e2 *= inv;
      bf16x8 o;
#pragma unroll
      for (int j = 0; j < 8; ++j) o[j] = (short)f2bf(e0 * bfs(a[q][j]) + e1 * bfs(b[q][j]) + e2 * bfs(cc[q][j]));
      if (ok[q]) *(bf16x8*)(O0 + (idx0 + q * stride) * 8) = o;
    }
  }
}

DI unsigned hkey(float s) {
  if (s == 0.f) s = 0.f;
  const _Float16 hv = (_Float16)s;
  const unsigned u = (unsigned)__builtin_bit_cast(unsigned short, hv);
  return (u & 0x8000u) ? (~u & 0xffffu) : (u | 0x8000u);
}

DI void phase_mix_b(int wv_, int vb_, int nvb_, char* ws_, const Ctx& p, char* smem) {
  u16* sc = (u16*)smem;
  unsigned* hist = (unsigned*)(smem + 65536);
  u16* sel = (u16*)(smem + 65536 + 4096);
  const u16* P = (const u16*)(ws_ + WS_P);
  for (int k_ = 0; k_ < (4096 + nvb_ - 1) / nvb_; ++k_) {
    const int it = (vb_ + k_ * nvb_ < 4096) ? vb_ + k_ * nvb_ : 4095;
    const int b = it & 7, qt = 511 - (it >> 3), t0 = qt * 8;
    const u16* Pb = P + (size_t)b * SEQ * 2304;
    {
      const int tid1 = tidx(wv_); const int c = tid1 & 31, h = (tid1 >> 5) & 1, wave = tid1 >> 6;
      const int hd = (c & 3) + 4 * ((c >> 3) & 1), qq = ((c >> 2) & 1) + 2 * (c >> 4);
      bf16x8 qa[2][4];
      float wf[2][2][8];
#pragma unroll
      for (int rb = 0; rb < 2; ++rb) {
#pragma unroll
        for (int ks = 0; ks < 4; ++ks) qa[rb][ks] = *(const bf16x8*)(Pb + (size_t)(t0 + rb * 4 + qq) * 2304 + 1536 + hd * 64 + ks * 16 + h * 8);
#pragma unroll
        for (int q2 = 0; q2 < 2; ++q2) {
          const bf16x8 wv = *(const bf16x8*)(Pb + (size_t)(t0 + rb * 4 + h + 2 * q2) * 2304 + 2112);
#pragma unroll
          for (int j = 0; j < 8; ++j) wf[rb][q2][j] = (bfs(wv[j]) * 0.35355339059327373f) * 0.125f;
        }
      }
      const int nkb = (t0 + 7) / 32 + 1;
#pragma unroll 1
      for (int kb0 = 0; kb0 < nkb; kb0 += 16) {
        bf16x8 kf[4][4];
#pragma unroll
        for (int u = 0; u < 4; ++u) {
          const int kb = kb0 + wave + 4 * u; const int kbc = kb < 127 ? kb : 127;
          const u16* kp = Pb + (size_t)(kbc * 32 + c) * 2304 + 2048 + h * 8;
#pragma unroll
          for (int ks = 0; ks < 4; ++ks) kf[u][ks] = *(const bf16x8*)(kp + ks * 16);
        }
#pragma unroll
        for (int u = 0; u < 4; ++u) {
          const int key = (kb0 + wave + 4 * u) * 32 + c;
#pragma unroll
          for (int rb = 0; rb < 2; ++rb) {
            f32x16 acc = zero16();
#pragma unroll
            for (int ks = 0; ks < 4; ++ks) acc = MFMA32(qa[rb][ks], kf[u][ks], acc);
            float s0 = 0.f, s1 = 0.f;
#pragma unroll
            for (int i = 0; i < 8; ++i) {
              const int hh = (i & 3) + 4 * ((i >> 2) & 1);
              const float a0 = acc[i], a1 = acc[8 + i];
              s0 += wf[rb][0][hh] * (a0 > 0.f ? a0 : 0.f); s1 += wf[rb][1][hh] * (a1 > 0.f ? a1 : 0.f);
            }
            const int q0 = rb * 4 + h, q1 = rb * 4 + h + 2;
            if (key <= t0 + q0) sc[q0 * 4096 + key] = (u16)hkey(s0);
            if (key <= t0 + q1) sc[q1 * 4096 + key] = (u16)hkey(s1);
          }
        }
      }
    }
    __syncthreads();
#pragma unroll 1
    for (int qs = 0; qs < 2; ++qs) {
      const int tid2 = tidx(wv_); const int lane = tid2 & 63, wave = tid2 >> 6;
      const int qsel = wave + 4 * qs;
      const int t = t0 + qsel, n = t + 1;
      const u16* myS = sc + qsel * 4096;
      unsigned* myH = hist + wave * 256;
      unsigned prefix = 0; int need = 256;
#pragma unroll 1
      for (int pass = 0; pass < 2; ++pass) {
        const int shift = 8 - 8 * pass;
        *(uint4*)(myH + lane * 4) = make_uint4(0, 0, 0, 0);
        asm volatile("s_waitcnt lgkmcnt(0)" ::: "memory");
        for (int j8 = lane * 8; j8 < n; j8 += 512) {
          const bf16x8 kv = *(const bf16x8*)(myS + j8);
#pragma unroll
          for (int e = 0; e < 8; ++e) {
            const unsigned u = (unsigned)(u16)kv[e];
            const bool ok = (j8 + e < n) && ((pass == 0) ? true : ((u >> 8) == prefix));
            if (ok) atomicAdd(&myH[(u >> shift) & 255], 1u);
          }
        }
        asm volatile("s_waitcnt lgkmcnt(0)" ::: "memory");
        uint4 hv = *(const uint4*)(myH + lane * 4);
        int tot = (int)(hv.x + hv.y + hv.z + hv.w);
        int incl = tot;
#pragma unroll
        for (int off = 1; off < 64; off <<= 1) { int v = shdown(incl, off); if (lane + off < 64) incl += v; }
        int above = incl - tot;
        bool hit = (above < need) && (need <= incl);
        int bin = 0, nn = need;
        if (hit) {
          int a = above;
          if (need <= a + (int)hv.w) { bin = 3; nn = need - a; }
          else { a += hv.w; if (need <= a + (int)hv.z) { bin = 2; nn = need - a; }
            else { a += hv.z; if (need <= a + (int)hv.y) { bin = 1; nn = need - a; } else { a += hv.y; bin = 0; nn = need - a; } } }
          bin += lane * 4;
        }
        unsigned long long mk = __ballot(hit);
        int src = mk ? (__ffsll((long long)mk) - 1) : 0;
        bin = shidx(bin, src); nn = shidx(nn, src);
        prefix = (prefix << 8) | (unsigned)bin; need = nn;
      }
      u16* mySel = sel + wave * 256;
      int cnt = 0;
      if (n <= 256) {
        for (int j = lane; j < 256; j += 64) mySel[j] = (u16)((j < n) ? j : 0);
        cnt = n;
      } else {
        int eqseen = 0;
        const unsigned long long lt = (1ull << lane) - 1ull;
        for (int j0 = 0; j0 < n; j0 += 64) {
          const int j = j0 + lane; const bool v = j < n;
          unsigned u = v ? (unsigned)myS[j] : 0u;
          const bool gt = v && (u > prefix), eq = v && (u == prefix);
          unsigned long long be = __ballot(eq);
          const bool take = gt || (eq && (eqseen + __popcll(be & lt) < need));
          unsigned long long bt = __ballot(take);
          int pos = cnt + __popcll(bt & lt);
          if (take && pos < 256) mySel[pos] = (u16)j;
          cnt += __popcll(bt); eqseen += __popcll(be);
        }
        if (cnt > 256) cnt = 256;
      }
      asm volatile("s_waitcnt lgkmcnt(0)" ::: "memory");
      {
        u16* gsel = (u16*)(ws_ + WS_SEL) + ((size_t)b * SEQ + t) * 256;
        unsigned char* gselb = (unsigned char*)(ws_ + WS_SELB) + ((size_t)b * SEQ + t) * 256;
        for (int j = lane; j < 256; j += 64) {
          const int tk = (int)mySel[j];
          gsel[j] = (u16)tk;
          gselb[j] = (unsigned char)t5_bucket(t - tk > 0 ? t - tk : 0);
        }
        if (lane == 0) ((int*)(ws_ + WS_CNT))[(size_t)b * SEQ + t] = cnt;
      }
      asm volatile("s_waitcnt lgkmcnt(0)" ::: "memory");
    }
    __syncthreads();
  }
}

DI void phase_mix_b2(int wv_, int vb_, int nvb_, char* ws_, const Ctx& p, char* smem) {
  const u16* P = (const u16*)(ws_ + WS_P);
  u16* Y = (u16*)(ws_ + WS_H);
  float* sbias = (float*)(smem + 65536);
  u16* selL = (u16*)(smem + 65536 + 2048);
  unsigned char* selbL = (unsigned char*)(smem + 65536 + 2048 + 2048);
  {
    const int tid = tidx(wv_);
    for (int i = tid; i < 512; i += 256) sbias[i] = p.rel_bias[(i >> 4) * 40 + 24 + (i & 15)];
  }
  __syncthreads();
  for (int ib = vb_; ib < 32768; ib += nvb_) {
    const int tid = tidx(wv_); const int lane = tid & 63, wave = tid >> 6, n16 = tid & 15, fq = (tid >> 4) & 3;
    const int b = ib & 7, r4 = ib >> 3, hkv = r4 >> 10, t = (r4 & 1023) * 4 + wave;
    const u16* Pb = P + (size_t)b * SEQ * 2304;
    u16* mySel = selL + wave * 256;
    unsigned char* mySelb = selbL + wave * 256;
    const size_t qrow = (size_t)b * SEQ + t;
    const int cnt = ((const int*)(ws_ + WS_CNT))[qrow];
    asm volatile("s_waitcnt lgkmcnt(0)" ::: "memory");
    *(uint2*)(mySel + lane * 4) = *(const uint2*)((const u16*)(ws_ + WS_SEL) + qrow * 256 + lane * 4);
    *(unsigned*)(mySelb + lane * 4) = *(const unsigned*)((const unsigned char*)(ws_ + WS_SELB) + qrow * 256 + lane * 4);
    asm volatile("s_waitcnt lgkmcnt(0)" ::: "memory");
    bf16x8 qf[2];
    {
      const u16* qp = Pb + (size_t)t * 2304 + (hkv * 4 + (n16 & 3)) * 64 + fq * 8;
      qf[0] = *(const bf16x8*)qp; qf[1] = *(const bf16x8*)(qp + 32);
      if (n16 >= 4) { qf[0] = zero8(); qf[1] = zero8(); }
    }
    f32x4 lg[16];
    char* Ks = smem + wave * 16384;
    bf16x8 vreg[16];
#define LOADKV(BASECOL, SH) { _Pragma("unroll") for (int rr = 0; rr < 16; ++rr) { \
      const unsigned vo_ = (unsigned)mySel[(SH) * 128 + rr * 8 + (lane >> 3)] * 4608u + (unsigned)(hkv * 128 + (lane & 7) * 16); \
      vreg[rr] = *(const bf16x8*)((const char*)(Pb + (BASECOL)) + (size_t)vo_); } }
#define LOADV(SH) LOADKV(1280, SH)
#define KWRITE() { _Pragma("unroll") for (int rr = 0; rr < 16; ++rr) { const int row_ = rr * 8 + (lane >> 3), piece_ = lane & 7; \
      *(bf16x8*)(Ks + row_ * 128 + ((piece_ ^ (row_ & 7)) * 16)) = vreg[rr]; } }
#define QKSTAGE(SH) { _Pragma("unroll") for (int kbl = 0; kbl < 8; ++kbl) { const int row_ = kbl * 16 + n16; \
      const bf16x8 k0_ = *(const bf16x8*)(Ks + row_ * 128 + ((fq ^ (row_ & 7)) * 16)); \
      const bf16x8 k1_ = *(const bf16x8*)(Ks + row_ * 128 + (((4 + fq) ^ (row_ & 7)) * 16)); \
      f32x4 a_ = {0.f, 0.f, 0.f, 0.f}; a_ = MFMA16(k0_, qf[0], a_); a_ = MFMA16(k1_, qf[1], a_); lg[(SH) * 8 + kbl] = a_; } }
    bf16x8 vreg2[16];
#define LOADKV2(BASECOL, SH) { _Pragma("unroll") for (int rr = 0; rr < 16; ++rr) { \
      const unsigned vo_ = (unsigned)mySel[(SH) * 128 + rr * 8 + (lane >> 3)] * 4608u + (unsigned)(hkv * 128 + (lane & 7) * 16); \
      vreg2[rr] = *(const bf16x8*)((const char*)(Pb + (BASECOL)) + (size_t)vo_); } }
#define KWRITE2() { _Pragma("unroll") for (int rr = 0; rr < 16; ++rr) { const int row_ = rr * 8 + (lane >> 3), piece_ = lane & 7; \
      *(bf16x8*)(Ks + row_ * 128 + ((piece_ ^ (row_ & 7)) * 16)) = vreg2[rr]; } }
    LOADKV(1024, 0)
    LOADKV2(1024, 1)
    asm volatile("s_waitcnt lgkmcnt(0)" ::: "memory");
    KWRITE()
    asm volatile("s_waitcnt lgkmcnt(0)" ::: "memory");
    QKSTAGE(0)
    asm volatile("s_waitcnt lgkmcnt(0)" ::: "memory");
    KWRITE2()
    LOADV(0)
    asm volatile("s_waitcnt lgkmcnt(0)" ::: "memory");
    QKSTAGE(1)
    asm volatile("s_waitcnt lgkmcnt(0)" ::: "memory");
    LOADKV2(1280, 1)
#undef LOADKV2
#undef KWRITE2
#undef KWRITE
#undef QKSTAGE
    float mx = -INFINITY;
#pragma unroll
    for (int kb = 0; kb < 16; ++kb)
#pragma unroll
      for (int i = 0; i < 4; ++i) {
        const int slot = kb * 16 + fq * 4 + i;
        const unsigned bk4 = *(const unsigned*)(mySelb + kb * 16 + fq * 4);
        const int bk = (bk4 >> (8 * i)) & 255;
        const float bv = sbias[bk * 16 + hkv * 4 + (n16 & 3)];
        float v = lg[kb][i] + bv;
        v = (slot < cnt) ? v : -INFINITY;
        lg[kb][i] = v; mx = fmaxf(mx, v);
      }
    mx = fmaxf(mx, shx(mx, 16)); mx = fmaxf(mx, shx(mx, 32));
    float sum = 0.f;
#pragma unroll
    for (int kb = 0; kb < 16; ++kb)
#pragma unroll
      for (int i = 0; i < 4; ++i) { float pv = __expf(lg[kb][i] - mx); lg[kb][i] = pv; sum += pv; }
    sum += shx(sum, 16); sum += shx(sum, 32);
    bf16x8 pall[8];
#pragma unroll
    for (int q = 0; q < 8; ++q)
#pragma unroll
      for (int j = 0; j < 4; ++j) { pall[q][j] = (short)f2bf(lg[2 * q][j]); pall[q][4 + j] = (short)f2bf(lg[2 * q + 1][j]); }
    char* Vs = smem + wave * 16384;
    float invs[4];
#pragma unroll
    for (int i = 0; i < 4; ++i) invs[i] = 1.0f / shidx(sum, i);
    f32x4 oacc[4];
#pragma unroll
    for (int cb = 0; cb < 4; ++cb) oacc[cb] = (f32x4){0.f, 0.f, 0.f, 0.f};
#pragma unroll
    for (int sh = 0; sh < 2; ++sh) {
      asm volatile("s_waitcnt lgkmcnt(0)" ::: "memory");
#pragma unroll
      for (int rr = 0; rr < 16; ++rr) {
        const int row = rr * 8 + (lane >> 3), piece = lane & 7;
        *(bf16x8*)(Vs + row * 128 + (((piece >> 1) ^ ((row >> 1) & 3)) * 32) + (piece & 1) * 16) = (sh == 0) ? vreg[rr] : vreg2[rr];
      }
      asm volatile("s_waitcnt lgkmcnt(0)" ::: "memory");
#pragma unroll
      for (int ks = 0; ks < 4; ++ks) {
        const bf16x8 pa = pall[sh * 4 + ks];
        const int rlo = ks * 32 + fq * 4 + (n16 >> 2);
        const int sw = (rlo >> 1) & 3;
#pragma unroll
        for (int cb = 0; cb < 4; ++cb) {
          const int off = ((cb ^ sw) * 32) + (n16 & 3) * 8;
          s16x4 lo = __builtin_amdgcn_ds_read_tr16_b64_v4i16((__attribute__((address_space(3))) s16x4*)(Vs + rlo * 128 + off));
          s16x4 hi = __builtin_amdgcn_ds_read_tr16_b64_v4i16((__attribute__((address_space(3))) s16x4*)(Vs + (16 + rlo) * 128 + off));
          bf16x8 vb = __builtin_shufflevector(lo, hi, 0, 1, 2, 3, 4, 5, 6, 7);
          oacc[cb] = MFMA16(pa, vb, oacc[cb]);
        }
      }
    }
#undef LOADV
#undef LOADKV
    if (fq == 0) {
      u16* yp = Y + qrow * 1024 + hkv * 256;
#pragma unroll
      for (int i = 0; i < 4; ++i)
#pragma unroll
        for (int cb = 0; cb < 4; ++cb) yp[i * 64 + cb * 16 + n16] = f2bf(oacc[cb][i] * invs[i]);
    }
  }
  __syncthreads();
}

DI float f4c(const float4& v, int k) { return k == 0 ? v.x : (k == 1 ? v.y : (k == 2 ? v.z : v.w)); }
template <int I> struct SolveRows {
  static DI void run(float (&U)[64], const u16* rsrc, const float* rsc, const float* sAm, const float4 (&cur)[16], float rhs) {
    float4 nxt[16]; float rhsn = 0.f;
    if constexpr (I + 1 < 64) {
#pragma unroll
      for (int q = 0; q < (I + 1 + 3) / 4; ++q) nxt[q] = *(const float4*)(sAm + (I + 1) * 68 + q * 4);
      rhsn = bf2f(rsrc[(I + 1) * 136]) * rsc[I + 1];
    }
    __builtin_amdgcn_sched_barrier(0);
    float a0 = rhs, a1 = 0.f, a2 = 0.f, a3 = 0.f;
#pragma unroll
    for (int j4 = 0; j4 < (I + 3) / 4; ++j4) {
      if (4 * j4 + 0 < I) a0 -= cur[j4].x * U[4 * j4 + 0];
      if (4 * j4 + 1 < I) a1 -= cur[j4].y * U[4 * j4 + 1];
      if (4 * j4 + 2 < I) a2 -= cur[j4].z * U[4 * j4 + 2];
      if (4 * j4 + 3 < I) a3 -= cur[j4].w * U[4 * j4 + 3];
    }
    U[I] = (a0 + a1) + (a2 + a3);
    if constexpr (I + 1 < 64) SolveRows<I + 1>::run(U, rsrc, rsc, sAm, nxt, rhsn);
  }
};
DI void phase_prep_c(int wv_, int vb_, int nvb_, char* ws_, const Ctx& p, char* smem, int half) {
  float* sAm = (float*)smem;
  float* sbeta = sAm + 64 * 68;
  float* sgc = sbeta + 64;
  float* sbg = sgc + 64;
  float* scw = sbg + 64;
  u16* sq = (u16*)(scw + 1536);
  u16* sk = sq + 64 * 136;
  u16* sv = sk + 64 * 136;
  const u16* PQ = (const u16*)(ws_ + WS_CQKV);
  const float* side = (const float*)(ws_ + WS_SIDE);
  u16* halo = (u16*)(ws_ + WS_HALO);
  u16* CW = (u16*)(ws_ + WS_CW); u16* CU = (u16*)(ws_ + WS_CU); u16* CQ = (u16*)(ws_ + WS_CQ);
  u16* CKT = (u16*)(ws_ + WS_CKT); u16* CQK = (u16*)(ws_ + WS_CQK);
  float* GL = (float*)(ws_ + WS_GL);
  const int tid = tidx(wv_), lane = tid & 63, wave = tid >> 6, c = lane & 31, h = lane >> 5;
  for (int k_ = 0; k_ < (2048 + nvb_ - 1) / nvb_; ++k_) {
    const int uix = (vb_ + k_ * nvb_ < 2048) ? vb_ + k_ * nvb_ : 2047;
    const int nc = uix & 31, hd = (uix >> 5) & 7, b = uix >> 8;
    const int n = half * 32 + nc;
    {
      const int tid = tidx(wv_);
      for (int i = tid; i < 1536; i += 256) scw[i] = p.c_conv_w[(i / 384) * 3072 + ((i % 384) >> 7) * 1024 + hd * 128 + (i & 127)];
      __syncthreads();
      const int i = tid >> 2, p4 = tid & 3;
#pragma unroll 1
      for (int which = 0; which < 3; ++which) {
        const int colbase = which * 1024 + hd * 128 + p4 * 32;
        bf16x8 xv[4][4];
#pragma unroll
        for (int j = 0; j < 4; ++j) {
          const int ri = i - 3 + j;
          const u16* src = PQ + ((size_t)b * 2048 + nc * 64 + (ri >= 0 || nc > 0 ? ri : 0)) * 3072 + colbase;
          const bool zr = (ri < 0 && nc == 0 && half == 0);
          if (ri < 0 && nc == 0 && half == 1) src = halo + ((size_t)b * 3 + (3 + ri)) * 3072 + colbase;
#pragma unroll
          for (int q = 0; q < 4; ++q) { bf16x8 t_ = *(const bf16x8*)(src + q * 8);
#pragma unroll
            for (int e = 0; e < 8; ++e) t_[e] = zr ? (short)0 : t_[e];
            xv[j][q] = t_; }
        }
        if (half == 0 && nc == 31 && i >= 61) {
#pragma unroll
          for (int q = 0; q < 4; ++q) *(bf16x8*)(halo + ((size_t)b * 3 + (i - 61)) * 3072 + colbase + q * 8) = xv[3][q];
        }
        float acc[32];
#pragma unroll
        for (int e = 0; e < 32; ++e) acc[e] = 0.f;
#pragma unroll
        for (int j = 0; j < 4; ++j) {
          const float* wp = scw + j * 384 + which * 128 + p4 * 32;
#pragma unroll
          for (int q = 0; q < 4; ++q) {
            const float4 wa = *(const float4*)(wp + q * 8), wb = *(const float4*)(wp + q * 8 + 4);
            acc[q * 8 + 0] += wa.x * bfs(xv[j][q][0]); acc[q * 8 + 1] += wa.y * bfs(xv[j][q][1]); acc[q * 8 + 2] += wa.z * bfs(xv[j][q][2]); acc[q * 8 + 3] += wa.w * bfs(xv[j][q][3]);
            acc[q * 8 + 4] += wb.x * bfs(xv[j][q][4]); acc[q * 8 + 5] += wb.y * bfs(xv[j][q][5]); acc[q * 8 + 6] += wb.z * bfs(xv[j][q][6]); acc[q * 8 + 7] += wb.w * bfs(xv[j][q][7]);
          }
        }
        float ss = 0.f;
#pragma unroll
        for (int e = 0; e < 32; ++e) { float a = acc[e]; a = a * __builtin_amdgcn_rcpf(1.0f + __expf(-a)); acc[e] = a; ss += a * a; }
        float scale = 1.f;
        if (which < 2) {
          ss += shx(ss, 1); ss += shx(ss, 2);
          scale = rsqrtf(ss + 1e-6f);
          if (which == 0) scale *= 0.08838834764831845f;
        }
        u16* dst = (which == 0 ? sq : (which == 1 ? sk : sv)) + i * 136 + p4 * 32;
#pragma unroll
        for (int q = 0; q < 4; ++q) {
          bf16x8 o;
#pragma unroll
          for (int e = 0; e < 8; ++e) o[e] = (short)f2bf(acc[q * 8 + e] * scale);
          *(bf16x8*)(dst + q * 8) = o;
        }
      }
    }
    if ((tidx(wv_) >> 6) == 0) {
      const int lane = tidx(wv_) & 63;
      const size_t tok = (size_t)b * SEQ + n * 64 + lane;
      float bb = side[tok * 16 + hd], aa = side[tok * 16 + 8 + hd];
      float beta = 1.0f / (1.0f + __expf(-bb));
      float xx = aa + p.c_dt_bias[hd];
      float sp = fmaxf(xx, 0.f) + log1pf(__expf(-fabsf(xx)));
      float gcv = -__expf(p.c_a_log[hd]) * sp;
#pragma unroll
      for (int off = 1; off < 64; off <<= 1) { float v = shup(gcv, off); if (lane >= off) gcv += v; }
      sbeta[lane] = beta; sgc[lane] = gcv; sbg[lane] = beta * __expf(gcv);
      if (lane == 63) GL[uix] = __expf(gcv);
    }
    __syncthreads();
    {
      const int tid = tidx(wv_); const int wave = tid >> 6, c = tid & 31, h = (tid >> 5) & 1;
      const int bi = wave >> 1, bj = wave & 1;
      f32x16 akk = zero16(), aqk = zero16();
#pragma unroll
      for (int ks = 0; ks < 8; ++ks) {
        bf16x8 ka = *(const bf16x8*)(sk + (bi * 32 + c) * 136 + ks * 16 + h * 8);
        bf16x8 qa = *(const bf16x8*)(sq + (bi * 32 + c) * 136 + ks * 16 + h * 8);
        bf16x8 kb = *(const bf16x8*)(sk + (bj * 32 + c) * 136 + ks * 16 + h * 8);
        akk = MFMA32(ka, kb, akk); aqk = MFMA32(qa, kb, aqk);
      }
      const int jj = bj * 32 + c;
      const float gj = sgc[jj];
      u16* qko = CQK + (size_t)uix * 4096;
#pragma unroll
      for (int i = 0; i < 16; ++i) {
        const int ii = bi * 32 + crow(i, h);
        const float dg = sgc[ii] - gj;
        const float dec = (jj <= ii) ? __expf(dg) : 0.f;
        sAm[ii * 68 + jj] = (jj < ii) ? sbeta[ii] * akk[i] * dec : 0.f;
        qko[ii * 64 + kpos(jj)] = f2bf(aqk[i] * dec);
      }
    }
    __syncthreads();
    {
      const int tid = tidx(wv_); const int wave = tid >> 6, lane = tid & 63;
      const int cw = wave * 64 + lane;
      const bool isu = wave < 2;
      const u16* rsrc = isu ? (sv + cw) : (sk + (cw - 128));
      const float* rsc = isu ? sbeta : sbg;
      float U[64];
      { float4 c0[16]; SolveRows<0>::run(U, rsrc, rsc, sAm, c0, bf2f(rsrc[0]) * rsc[0]); }
      if (isu) {
        u16* dst = CU + ((size_t)uix * 128 + cw) * 64;
#pragma unroll
        for (int g8 = 0; g8 < 8; ++g8) {
          bf16x8 o;
#pragma unroll
          for (int e = 0; e < 8; ++e) {
            const int pos = g8 * 8 + e;
            const int tb = pos >> 5, hh = (pos >> 4) & 1, ii = pos & 15;
            o[e] = (short)f2bf(U[tb * 32 + crow(ii, hh)]);
          }
          *(bf16x8*)(dst + g8 * 8) = o;
        }
      } else {
        u16* dst = CW + (size_t)uix * 8192 + kpos(cw - 128);
#pragma unroll
        for (int i = 0; i < 64; ++i) dst[i * 128] = f2bf(U[i]);
      }
    }
    {
      const int tid = tidx(wv_);
      const int i = tid >> 2, p4 = tid & 3;
      const float eg = __expf(sgc[i]);
      u16* dst = CQ + (size_t)uix * 8192 + i * 128 + p4 * 32;
      const u16* srow = sq + i * 136 + p4 * 32;
#pragma unroll
      for (int g8 = 0; g8 < 4; ++g8) {
        bf16x8 o;
#pragma unroll
        for (int e = 0; e < 8; ++e) {
          const int pos = g8 * 8 + e;
          const int s = pos >> 4, hh = (pos >> 3) & 1, j = pos & 7;
          const int d = 16 * s + 8 * (j >> 2) + 4 * hh + (j & 3);
          o[e] = (short)f2bf(bf2f(srow[d]) * eg);
        }
        *(bf16x8*)(dst + g8 * 8) = o;
      }
      const int d = tid & 127, th = tid >> 7;
      const float gl = sgc[63];
      u16* dk = CKT + ((size_t)uix * 128 + d) * 64 + th * 32;
#pragma unroll
      for (int g8 = 0; g8 < 4; ++g8) {
        bf16x8 o;
#pragma unroll
        for (int e = 0; e < 8; ++e) {
          const int pos = g8 * 8 + e;
          const int s = pos >> 4, hh = (pos >> 3) & 1, j = pos & 7;
          const int tt = th * 32 + 16 * s + 8 * (j >> 2) + 4 * hh + (j & 3);
          o[e] = (short)f2bf(bf2f(sk[tt * 136 + d]) * __expf(gl - sgc[tt]));
        }
        *(bf16x8*)(dk + g8 * 8) = o;
      }
    }
    __syncthreads();
  }
}

DI void phase_scan_c(int wv_, int vb_, int nvb_, char* ws_, const Ctx& p, char* smem, int half) {
  const u16* CW = (const u16*)(ws_ + WS_CW); const u16* CU = (const u16*)(ws_ + WS_CU); const u16* CQ = (const u16*)(ws_ + WS_CQ);
  const u16* CKT = (const u16*)(ws_ + WS_CKT); const u16* CQK = (const u16*)(ws_ + WS_CQK);
  const float* GL = (const float*)(ws_ + WS_GL);
  float* ST = (float*)(ws_ + WS_STATE);
  u16* O = (u16*)(ws_ + WS_H);
  u16* sW = (u16*)smem;
  u16* sQ = sW + 64 * 136;
  u16* sKT = sQ + 64 * 136;
  u16* sQK = sKT + 128 * 72;
  const int tid = tidx(wv_), lane = tid & 63, wave = tid >> 6, c = lane & 31, h = lane >> 5;
  if ((vb_ >> 1) < 64 && (vb_ & 1)) { for (int q_ = 0; q_ < 66; ++q_) __syncthreads(); }
  if ((vb_ >> 1) < 64 && !(vb_ & 1)) {
    const int blk = vb_ >> 1;
    const int b = blk >> 3, hd = blk & 7, dv0 = wave * 32;
    f32x16 S[4];
    float* stp = ST + ((size_t)(blk * 4 + wave) * 64) * 64 + lane;
    if (half == 0) {
#pragma unroll
      for (int mb = 0; mb < 4; ++mb) S[mb] = zero16();
    } else {
#pragma unroll
      for (int mb = 0; mb < 4; ++mb)
#pragma unroll
        for (int i = 0; i < 16; ++i) S[mb][i] = stp[(mb * 16 + i) * 64];
    }
    bf16x8 gw[4], gq[4], gk[4], gqk[2];
#define SLOAD(UIX) { const size_t u_ = (UIX); \
      _Pragma("unroll") for (int i = 0; i < 4; ++i) { gw[i] = *(const bf16x8*)(CW + u_ * 8192 + (size_t)(tid + 256 * i) * 8); gq[i] = *(const bf16x8*)(CQ + u_ * 8192 + (size_t)(tid + 256 * i) * 8); \
        gk[i] = *(const bf16x8*)(CKT + u_ * 8192 + (size_t)(tid + 256 * i) * 8); } \
      _Pragma("unroll") for (int i = 0; i < 2; ++i) gqk[i] = *(const bf16x8*)(CQK + u_ * 4096 + (size_t)(tid + 256 * i) * 8); }
#define SWRITE() { _Pragma("unroll") for (int i = 0; i < 4; ++i) { const int id_ = tid + 256 * i; \
        *(bf16x8*)(sW + (id_ >> 4) * 136 + (id_ & 15) * 8) = gw[i]; *(bf16x8*)(sQ + (id_ >> 4) * 136 + (id_ & 15) * 8) = gq[i]; \
        *(bf16x8*)(sKT + (id_ >> 3) * 72 + (id_ & 7) * 8) = gk[i]; } \
      _Pragma("unroll") for (int i = 0; i < 2; ++i) { const int id_ = tid + 256 * i; *(bf16x8*)(sQK + (id_ >> 3) * 72 + (id_ & 7) * 8) = gqk[i]; } }
    SLOAD((size_t)blk * 32)
    __syncthreads();
    SWRITE()
    __syncthreads();
#pragma unroll 1
    for (int nc = 0; nc < 32; ++nc) {
      const size_t uix = (size_t)blk * 32 + nc;
      const float egl = GL[uix];
      bf16x8 ucur[4];
#pragma unroll
      for (int tb = 0; tb < 2; ++tb) { ucur[2 * tb] = *(const bf16x8*)(CU + (uix * 128 + dv0 + c) * 64 + h * 16 + tb * 32); ucur[2 * tb + 1] = *(const bf16x8*)(CU + (uix * 128 + dv0 + c) * 64 + h * 16 + tb * 32 + 8); }
      const u16* Wp = sW + c * 136 + h * 8;
      const u16* Qp = sQ + c * 136 + h * 8;
      const u16* KTp = sKT + c * 72 + h * 8;
      const u16* QKp = sQK + c * 72 + h * 8;
      f32x16 X[2], Oa[2];
      X[0] = zero16(); X[1] = zero16(); Oa[0] = zero16(); Oa[1] = zero16();
#pragma unroll
      for (int mb = 0; mb < 4; ++mb) {
#pragma unroll
        for (int s = 0; s < 2; ++s) {
          const bf16x8 sb = pack8(S[mb], s);
#pragma unroll
          for (int tb = 0; tb < 2; ++tb) {
            bf16x8 a = *(const bf16x8*)(Wp + tb * 32 * 136 + mb * 32 + s * 16);
            bf16x8 a2 = *(const bf16x8*)(Qp + tb * 32 * 136 + mb * 32 + s * 16);
            X[tb] = MFMA32(a, sb, X[tb]);
            Oa[tb] = MFMA32(a2, sb, Oa[tb]);
          }
        }
      }
      bf16x8 vb[2][2];
#pragma unroll
      for (int tb = 0; tb < 2; ++tb) {
#pragma unroll
        for (int i = 0; i < 8; ++i) { X[tb][i] = bfs(ucur[2 * tb][i]) - X[tb][i]; X[tb][8 + i] = bfs(ucur[2 * tb + 1][i]) - X[tb][8 + i]; }
        vb[tb][0] = pack8(X[tb], 0); vb[tb][1] = pack8(X[tb], 1);
      }
      { const int ncn = nc < 31 ? nc + 1 : 31; SLOAD((size_t)blk * 32 + ncn) }
#pragma unroll
      for (int tb = 0; tb < 2; ++tb)
#pragma unroll
        for (int tb2 = 0; tb2 < 2; ++tb2)
#pragma unroll
          for (int s = 0; s < 2; ++s) {
            bf16x8 a = *(const bf16x8*)(QKp + tb * 32 * 72 + tb2 * 32 + s * 16);
            Oa[tb] = MFMA32(a, vb[tb2][s], Oa[tb]);
          }
#pragma unroll
      for (int mb = 0; mb < 4; ++mb) {
#pragma unroll
        for (int i = 0; i < 16; ++i) S[mb][i] *= egl;
#pragma unroll
        for (int tb = 0; tb < 2; ++tb)
#pragma unroll
          for (int s = 0; s < 2; ++s) {
            bf16x8 a = *(const bf16x8*)(KTp + mb * 32 * 72 + tb * 32 + s * 16);
            S[mb] = MFMA32(a, vb[tb][s], S[mb]);
          }
      }
      u16* op = O + ((size_t)b * SEQ + (size_t)(half * 32 + nc) * 64) * 1024 + hd * 128 + dv0 + c;
#pragma unroll
      for (int tb = 0; tb < 2; ++tb)
#pragma unroll
        for (int i = 0; i < 16; ++i) op[(size_t)(tb * 32 + crow(i, h)) * 1024] = f2bf(Oa[tb][i]);
      __syncthreads();
      SWRITE()
      __syncthreads();
    }
#undef SLOAD
#undef SWRITE
    if (half == 0) {
#pragma unroll
      for (int mb = 0; mb < 4; ++mb)
#pragma unroll
        for (int i = 0; i < 16; ++i) stp[(mb * 16 + i) * 64] = S[mb][i];
    }
  }
}

DI void phase_outnorm_c(int wv_, int vb_, int nvb_, char* ws_, const Ctx& p) {
  u16* O = (u16*)(ws_ + WS_H); const u16* G = (const u16*)(ws_ + WS_CG);
  const int tid = tidx(wv_); const int e = tid & 15;
  float og[8];
#pragma unroll
  for (int j = 0; j < 8; ++j) og[j] = p.c_o_gain[e * 8 + j];
  const size_t stride = (size_t)nvb_ * 256, total = (size_t)NTOK * 8 * 16;
  for (size_t idx0 = (size_t)vb_ * 256 + tid; idx0 < total; idx0 += 4 * stride) {
    bf16x8 ov[4], gv[4]; bool ok[4];
#pragma unroll
    for (int q = 0; q < 4; ++q) { const size_t idx = idx0 + q * stride; ok[q] = idx < total; const size_t rowh = (ok[q] ? idx : idx0) >> 4;
      ov[q] = *(const bf16x8*)(O + rowh * 128 + e * 8); gv[q] = *(const bf16x8*)(G + rowh * 128 + e * 8); }
#pragma unroll
    for (int q = 0; q < 4; ++q) {
      float f[8]; float ss = 0.f;
#pragma unroll
      for (int j = 0; j < 8; ++j) { f[j] = bfs(ov[q][j]); ss += f[j] * f[j]; }
      ss += shx(ss, 1); ss += shx(ss, 2); ss += shx(ss, 4); ss += shx(ss, 8);
      const float rn = rsqrtf(ss * (1.0f / 128.0f) + 1e-6f);
      bf16x8 o;
#pragma unroll
      for (int j = 0; j < 8; ++j) { float gt = bfs(gv[q][j]); float sl = gt * __builtin_amdgcn_rcpf(1.0f + __expf(-gt)); o[j] = (short)f2bf(f[j] * rn * og[j] * sl); }
      if (ok[q]) *(bf16x8*)(O + ((idx0 + q * stride) >> 4) * 128 + e * 8) = o;
    }
  }
}

#define XB_TMO      128
#define XB_XCNT(j)  (256  + 64 * (j))
#define XB_XSUB(j)  (1280 + 64 * (j))
#define XB_XGEN(j)  (2304 + 64 * (j))
#define XB_TOP      3328
#define XB_TOPGEN   3392
#define XCD_BAR_WORDS 3456
#define XB_SPIN_CAP (1u << 23)
DI unsigned xb_ld(unsigned* p)              { return __hip_atomic_load(p, __ATOMIC_RELAXED, __HIP_MEMORY_SCOPE_AGENT); }
DI unsigned xb_add(unsigned* p, unsigned v) { return __hip_atomic_fetch_add(p, v, __ATOMIC_RELAXED, __HIP_MEMORY_SCOPE_AGENT); }
DI unsigned xb_xcc_id() { return (unsigned)__builtin_amdgcn_s_getreg((3 << 11) | 20) & 0xFu; }
#define XB_SPIN(cond, bar) do { unsigned _sp = 0; while (cond) { __builtin_amdgcn_s_sleep(1); \
    if ((++_sp & 255u) == 0u) { if (xb_ld(&(bar)[XB_TMO])) break; if (_sp > XB_SPIN_CAP) { atomicAdd(&(bar)[XB_TMO], 1u); break; } } } } while (0)
struct XcdBarrier { unsigned* bar; unsigned x; volatile PG8_LAS unsigned* st; };
DI void xcd_barrier_complete(unsigned* bar, unsigned x, unsigned& nloc, unsigned& nx) {
    const unsigned G = gridDim.x;
    unsigned sum, cnt, mine, sp = 0u;
    for (;;) {
        sum = 0u; cnt = 0u; mine = 0u;
#pragma unroll
        for (unsigned j = 0; j < 16; ++j) { const unsigned c = xb_ld(&bar[XB_XCNT(j)]); sum += c; cnt += (c > 0u) ? 1u : 0u; mine = (j == x) ? c : mine; }
        if (sum == G) break;
        __builtin_amdgcn_s_sleep(1);
        if ((++sp & 255u) == 0u) { if (xb_ld(&bar[XB_TMO])) break; if (sp > XB_SPIN_CAP) { atomicAdd(&bar[XB_TMO], 1u); break; } }
    }
    nloc = mine > 0u ? mine : 1u; nx = cnt > 0u ? cnt : 1u;
}
DI void xcd_barrier(char* ws_base, char* lds_base, bool leader_thread) {
    asm volatile("s_waitcnt vmcnt(0)" ::: "memory");
    __syncthreads();
    if (leader_thread) {
        XcdBarrier b; b.bar = (unsigned*)(ws_base + WS_BAR); b.x = xb_xcc_id(); b.st = (volatile PG8_LAS unsigned*)(lds_base + 2 * HALF_LDS);
        unsigned* bar = b.bar;
        __builtin_amdgcn_s_waitcnt(0);
        unsigned nloc = b.st[0], nx = b.st[1];
        if (nloc == 0u) { xcd_barrier_complete(bar, b.x, nloc, nx); b.st[0] = nloc; b.st[1] = nx; }
        const unsigned old = xb_add(&bar[XB_XSUB(b.x)], 1u);
        const unsigned gen = old / nloc;
        if (old + 1u == (gen + 1u) * nloc) {
            __builtin_amdgcn_fence(__ATOMIC_RELEASE, "agent");
            asm volatile("s_waitcnt vmcnt(0)" ::: "memory");
            const unsigned og = xb_add(&bar[XB_TOP], 1u);
            const unsigned tg = og / nx;
            if (og + 1u == (tg + 1u) * nx) xb_add(&bar[XB_TOPGEN], 1u);
            else XB_SPIN(xb_ld(&bar[XB_TOPGEN]) == tg, bar);
            __builtin_amdgcn_fence(__ATOMIC_ACQUIRE, "agent");
            xb_add(&bar[XB_XGEN(b.x)], 1u);
            asm volatile("s_waitcnt vmcnt(0)" ::: "memory");
        } else {
            XB_SPIN(xb_ld(&bar[XB_XGEN(b.x)]) == gen, bar);
            __builtin_amdgcn_fence(__ATOMIC_ACQUIRE, "agent");
            asm volatile("s_waitcnt vmcnt(0)" ::: "memory");
        }
    }
    __syncthreads();
}

template <class Epi>
DI void run_gemm(int wv8_, const u16* A, const u16* Bt, int N, int K, int half, const Epi& E, int G_ = -1, int c_ = -1) {
  extern __shared__ __attribute__((aligned(16))) char smem0[];
  pg8::Gemm g; g.A = A; g.Bt = Bt; g.M = (half < 0) ? NTOK : NTOK / 2; g.N = N; g.K = K; g.half = half;
  pg8::StaticOrder S; S.init(g.M, g.N, G_ > 0 ? G_ : (int)gridDim.x, G_ > 0 ? c_ : (int)blockIdx.x);
  pg8::gemm_phase<Epi, pg8::StaticOrder>((PG8_LAS unsigned char*)smem0, g, S, E, tidx(wv8_));
  __syncthreads();
}

__global__ void __launch_bounds__(512, 2) mega(Params pp) {
  extern __shared__ __attribute__((aligned(16))) char smem0[];
  cg::grid_group grid = cg::this_grid();
  const int wv8_ = __builtin_amdgcn_readfirstlane((int)threadIdx.x >> 6);
  const int hb_ = wv8_ >> 2, wv_ = wv8_ & 3;
  const int vb_ = (int)blockIdx.x * 2 + hb_, nvb_ = (int)gridDim.x * 2;
  {
    volatile PG8_LAS unsigned* st = (volatile PG8_LAS unsigned*)(smem0 + 2 * HALF_LDS);
    const bool lead0 = tidx(wv8_) == 0;
    if (lead0) { st[0] = 0u; st[1] = 0u; (void)xb_add(&((unsigned*)(pp.c.ws + WS_BAR))[XB_XCNT(xb_xcc_id())], 1u); }
    __syncthreads();
  }
  if (pp.ph1 < 0) grid.sync();
#pragma unroll 1
  for (int ph = pp.ph0; ph < pp.ph1; ++ph) {
    const Ctx& p = pp.c;
    size_t wsoff_ = 0; asm volatile("" : "+s"(wsoff_));
    char* ws_ = pp.c.ws + wsoff_;
    unsigned smoff_ = 0; asm volatile("" : "+v"(smoff_));
    char* smem = smem0 + hb_ * HALF_LDS + smoff_;
    const u16* WT = (const u16*)(ws_ + WS_WT);
    u16* H = (u16*)(ws_ + WS_H);
    u16* Pm = (u16*)(ws_ + WS_P);
    const int code = pp.ops[ph];
    const int op = code & 15, l = (code >> 4) & 3, half = (code >> 6) & 1;
    const int kind = l % 3, j = l / 3;
    const float* xcur = (code >> 7) ? p.x : p.out;
    switch (op) {
      case OP_CONVERT: phase_convert(wv_, vb_, nvb_, ws_, p, smem); break;
      case OP_NORM_MIX: phase_norm(wv_, vb_, nvb_, xcur, p.norm_mix + l * DM, H); break;
      case OP_GEMM_IN:
        if (kind == 0) { pg8::EpiB16HN E; E.O = Pm; E.ldc = 4608; E.ncols_norm = 3072; E.nq_cols = 1536; E.gq = p.a_q_gain + j * 64; E.gk = p.a_k_gain + j * 64; E.T = (PG8_LAS float*)(smem0 + 131072);
          run_gemm(wv8_, H, WT + (size_t)j * 4718592u, 4608, 1024, -1, E); }
        else if (kind == 1) { pg8::EpiB16HN E; E.O = Pm; E.ldc = 2304; E.ncols_norm = 1280; E.nq_cols = 1024; E.gq = p.b_q_gain; E.gk = p.b_k_gain; E.T = (PG8_LAS float*)(smem0 + 131072);
          run_gemm(wv8_, H, WT + wOff(4), 2304, 1024, -1, E); }
        else { pg8::EpiCIn E; E.Q = (u16*)(ws_ + WS_CQKV); E.G = (u16*)(ws_ + WS_CG); E.S = (float*)(ws_ + WS_SIDE); E.half = half;
          run_gemm(wv8_, H, WT + wOff(6), 4352, 1024, half, E); }
        break;
      case OP_HEADNORM:
        if (kind == 0) phase_headnorm(wv_, vb_, nvb_, Pm, 4608, 48, 24, p.a_q_gain + j * 64, p.a_k_gain + j * 64);
        else phase_headnorm(wv_, vb_, nvb_, Pm, 2304, 20, 16, p.b_q_gain, p.b_k_gain);
        break;
      case OP_ATTN_A: phase_attn_a(wv_, vb_, nvb_, ws_, p, smem); break;
      case OP_COMBINE_A: phase_combine_a(wv_, vb_, nvb_, ws_, p); break;
      case OP_GEMM_OUT:
      case OP_GEMM_W2: {
        pg8::EpiResid E; E.C = p.out; E.X = xcur;
        const u16* Ag = H; int Kg = 1024; unsigned wo = wOff(7);
        if (op == OP_GEMM_W2) { Ag = Pm; Kg = 4096; wo = wOff(12) + (unsigned)l * 4194304u; }
        else if (kind == 0) { Kg = 512; wo = wOff(2) + (unsigned)j * 524288u; }
        else if (kind == 1) { wo = wOff(5); }
        run_gemm(wv8_, Ag, WT + wo, 1024, Kg, -1, E);
        break; }
      case OP_MIX_B: if (half == 0) phase_mix_b(wv_, vb_, nvb_, ws_, p, smem); else phase_mix_b2(wv_, vb_, nvb_, ws_, p, smem); break;
      case OP_PREP_C: phase_prep_c(wv_, vb_, nvb_, ws_, p, smem, half); break;
      case OP_SCAN_C: phase_scan_c(wv_, vb_, nvb_, ws_, p, smem, half); break;
      case OP_SCAN_GEMM:
        if ((int)blockIdx.x < 64) phase_scan_c(wv_, vb_, nvb_, ws_, p, smem, 0);
        else { pg8::EpiCIn E; E.Q = (u16*)(ws_ + WS_CQKV); E.G = (u16*)(ws_ + WS_CG); E.S = (float*)(ws_ + WS_SIDE); E.half = 1;
          run_gemm(wv8_, H, WT + wOff(6), 4352, 1024, 1, E, (int)gridDim.x - 64, (int)blockIdx.x - 64); }
        break;
      case OP_OUTNORM_C: phase_outnorm_c(wv_, vb_, nvb_, ws_, p); break;
      case OP_NORM_MLP: phase_norm(wv_, vb_, nvb_, xcur, p.norm_mlp + l * DM, H); break;
      case OP_GEMM_W1: { pg8::EpiB16<1> E; E.O = Pm; E.ldc = 4096; run_gemm(wv8_, H, WT + wOff(8) + (size_t)l * 4194304u, 4096, 1024, -1, E); break; }
      default: break;
    }
    const bool noseam = (op == OP_CONVERT) && half;
    if (ph + 1 < pp.ph1 && !noseam) xcd_barrier(ws_, smem0, tidx(wv8_) == 0);
  }
}

#ifndef MIXMASK
#define MIXMASK 15
#endif
#ifndef MULTI_LAUNCH
#define MULTI_LAUNCH 0
#endif
#ifndef REP_W1
#define REP_W1 1
#endif
#ifndef REP_MIXB
#define REP_MIXB 1
#endif
#ifndef REP_MIXB2
#define REP_MIXB2 1
#endif
#ifndef REP_C
#define REP_C 1
#endif
#ifndef REP_SCAN
#define REP_SCAN 1
#endif
#ifndef REP_ATTN
#define REP_ATTN 1
#endif
#ifndef REP_NORM
#define REP_NORM 1
#endif

extern "C" void kernel_launch(void* const* d_in, const int* in_sizes, int n_in, void* d_out, int out_size, void* d_ws, size_t ws_size, hipStream_t stream) {
  static int grid_blocks = 0;
  if (grid_blocks == 0) {
    if (n_in != 20 || ws_size < WS_END) { fprintf(stderr, "kernel_launch: bad n_in %d or ws %zu\n", n_in, ws_size); grid_blocks = -1; return; }
    int dev = 0, cus = 0, per_cu = 0;
    hipGetDevice(&dev);
    hipDeviceGetAttribute(&cus, hipDeviceAttributeMultiprocessorCount, dev);
    if (hipFuncSetAttribute((const void*)mega, hipFuncAttributeMaxDynamicSharedMemorySize, LDS_BYTES) != hipSuccess) { grid_blocks = -1; return; }
    if (hipOccupancyMaxActiveBlocksPerMultiprocessor(&per_cu, (const void*)mega, 512, LDS_BYTES) != hipSuccess || per_cu < 1) per_cu = 1;
    per_cu = 1;
    grid_blocks = cus * per_cu;
    grid_blocks &= ~7;
    fprintf(stderr, "kernel_launch: cus %d per_cu %d grid %d\n", cus, per_cu, grid_blocks);
  }
  if (grid_blocks < 0) return;
  Params p{};
  Ctx& c = p.c;
  c.x = (const float*)d_in[0]; c.rel_bias = (const float*)d_in[1]; c.norm_mix = (const float*)d_in[2]; c.norm_mlp = (const float*)d_in[3];
  c.a_q_gain = (const float*)d_in[7]; c.a_k_gain = (const float*)d_in[8];
  c.b_q_gain = (const float*)d_in[11]; c.b_k_gain = (const float*)d_in[12];
  c.c_conv_w = (const float*)d_in[15]; c.c_a_log = (const float*)d_in[16]; c.c_dt_bias = (const float*)d_in[17]; c.c_o_gain = (const float*)d_in[18];
  c.wbase[0] = (const float*)d_in[6]; c.wbase[1] = (const float*)d_in[9]; c.wbase[2] = (const float*)d_in[10]; c.wbase[3] = (const float*)d_in[13];
  c.wbase[4] = (const float*)d_in[14]; c.wbase[5] = (const float*)d_in[19]; c.wbase[6] = (const float*)d_in[4]; c.wbase[7] = (const float*)d_in[5];
  c.out = (float*)d_out; c.ws = (char*)d_ws;
  int np = 0;
  bool x_in_out = false;
  auto add = [&](int op, int l, int half) {
    int rep = 1;
    if (op == OP_GEMM_W1) rep = REP_W1;
    if (op == OP_MIX_B) rep = half ? REP_MIXB2 : REP_MIXB;
    if (op == OP_PREP_C) rep = REP_C;
    if (op == OP_SCAN_C) rep = REP_SCAN;
    if (op == OP_ATTN_A) rep = REP_ATTN;
    if (op == OP_NORM_MLP || op == OP_NORM_MIX) rep = REP_NORM;
    for (int r = 0; r < rep; ++r) p.ops[np++] = (unsigned char)(op | (l << 4) | (half << 6) | (x_in_out ? 0 : 128));
    if (op == OP_GEMM_OUT || op == OP_GEMM_W2) x_in_out = true;
  };
  add(OP_CONVERT, 0, (MIXMASK & 1) ? 1 : 0);
#ifdef REP_SYNC
  for (int q = 0; q < REP_SYNC; ++q) p.ops[np++] = 15;
#endif
  for (int l = 0; l < 4; ++l) {
    const int kind = l % 3;
    if ((MIXMASK >> l) & 1) {
      add(OP_NORM_MIX, l, 0);
      if (kind == 0) { add(OP_GEMM_IN, l, 0); add(OP_ATTN_A, l, 0); add(OP_COMBINE_A, l, 0); add(OP_GEMM_OUT, l, 0); }
      else if (kind == 1) { add(OP_GEMM_IN, l, 0); add(OP_MIX_B, l, 0); add(OP_MIX_B, l, 1); add(OP_GEMM_OUT, l, 0); }
      else { add(OP_GEMM_IN, l, 0); add(OP_PREP_C, l, 0); add(OP_SCAN_GEMM, l, 0); add(OP_PREP_C, l, 1); add(OP_SCAN_C, l, 1); add(OP_OUTNORM_C, l, 0); add(OP_GEMM_OUT, l, 0); }
    }
    add(OP_NORM_MLP, l, 0); add(OP_GEMM_W1, l, 0); add(OP_GEMM_W2, l, 0);
  }
#if MULTI_LAUNCH
  for (int i = 0; i < np; ++i) {
    p.ph0 = i; p.ph1 = i + 1;
    hipLaunchKernelGGL(mega, dim3(grid_blocks), dim3(512), LDS_BYTES, stream, p);
  }
#else
  p.ph0 = 0; p.ph1 = np;
  (void)hipMemsetAsync((char*)d_ws + WS_BAR, 0, XCD_BAR_WORDS * 4, stream);
  void* args[] = {&p};
  hipError_t e = hipLaunchCooperativeKernel((const void*)mega, dim3(grid_blocks), dim3(512), args, LDS_BYTES, stream);
  if (e != hipSuccess) fprintf(stderr, "cooperative launch failed: %s (grid %d)\n", hipGetErrorString(e), grid_blocks);
#endif
}
```

```cpp
#include <hip/hip_runtime.h>
#include <hip/hip_cooperative_groups.h>
#include <stdint.h>
#include <cstdio>
namespace cg = cooperative_groups;

typedef unsigned short u16;
typedef __attribute__((ext_vector_type(8))) short bf16x8;
typedef __attribute__((ext_vector_type(4))) short s16x4;
typedef __attribute__((ext_vector_type(16))) float f32x16;
typedef __attribute__((ext_vector_type(4))) float f32x4;
#define DI __device__ __forceinline__
#define MFMA32(a, b, c) __builtin_amdgcn_mfma_f32_32x32x16_bf16((a), (b), (c), 0, 0, 0)
#define MFMA16(a, b, c) __builtin_amdgcn_mfma_f32_16x16x32_bf16((a), (b), (c), 0, 0, 0)

constexpr int NTOK = 32768, DM = 1024, SEQ = 4096;
constexpr size_t MiB = 1ull << 20;
constexpr size_t WS_WT = 0, WS_H = 102 * MiB, WS_P = 166 * MiB, WS_E = 454 * MiB, WS_LSE = 486 * MiB,
                 WS_SIDE = 489 * MiB, WS_STATE = 491 * MiB, WS_HALO = 495 * MiB, WS_GL = 495 * MiB + 512 * 1024,
                 WS_BAR = 495 * MiB + 768 * 1024, WS_END = 496 * MiB;
constexpr size_t WS_CQKV = WS_P, WS_CW = WS_P + 96 * MiB, WS_CU = WS_CW + 32 * MiB, WS_CQ = WS_CU + 32 * MiB,
                 WS_CKT = WS_CQ + 32 * MiB, WS_CQK = WS_CKT + 32 * MiB, WS_CG = WS_CQK + 16 * MiB;
static_assert(WS_CG + 64 * MiB <= WS_LSE, "layer C carve-out");
constexpr size_t WS_SEL = WS_P + 150 * MiB, WS_SELB = WS_P + 170 * MiB, WS_CNT = WS_P + 180 * MiB;
constexpr int HALF_LDS = 76800;
constexpr int LDS_BYTES = 2 * HALF_LDS + 16;

enum { OP_CONVERT = 0, OP_NORM_MIX, OP_GEMM_IN, OP_ATTN_A, OP_COMBINE_A, OP_GEMM_OUT, OP_MIX_B, OP_PREP_C, OP_SCAN_C,
       OP_OUTNORM_C, OP_NORM_MLP, OP_GEMM_W1, OP_GEMM_W2, OP_HEADNORM, OP_SCAN_GEMM };

struct Ctx {
  const float* x; const float* rel_bias; const float* norm_mix; const float* norm_mlp;
  const float* a_q_gain; const float* a_k_gain; const float* b_q_gain; const float* b_k_gain;
  const float* c_conv_w; const float* c_a_log; const float* c_dt_bias; const float* c_o_gain;
  const float* wbase[8];
  float* out; char* ws;
};
struct Params { Ctx c; int ph0; int ph1; unsigned char ops[64]; };

constexpr int cK[16] = {1024, 1024, 512, 512, 1024, 1024, 1024, 1024, 1024, 1024, 1024, 1024, 4096, 4096, 4096, 4096};
constexpr int cN[16] = {4608, 4608, 1024, 1024, 2120, 1024, 4112, 1024, 4096, 4096, 4096, 4096, 1024, 1024, 1024, 1024};
constexpr int cNpad[16] = {4608, 4608, 1024, 1024, 2304, 1024, 4352, 1024, 4096, 4096, 4096, 4096, 1024, 1024, 1024, 1024};
constexpr int cBase[16] = {0, 0, 1, 1, 2, 3, 4, 5, 6, 6, 6, 6, 7, 7, 7, 7};
constexpr unsigned cSrcOff[16] = {0, 1024u * 4608u, 0, 512u * 1024u, 0, 0, 0, 0, 0, 4194304u, 2u * 4194304u, 3u * 4194304u, 0, 4194304u, 2u * 4194304u, 3u * 4194304u};
constexpr unsigned wOff(int i) { unsigned o = 0; for (int k = 0; k < i; ++k) o += (unsigned)cK[k] * (unsigned)cNpad[k]; return o; }
constexpr int wTileStart(int i) { int o = 0; for (int k = 0; k < i; ++k) o += (cK[k] / 64) * (cNpad[k] / 64); return o; }
static_assert((size_t)wOff(16) * 2 <= 102 * MiB, "WT region");

template <class T> DI T* lau(T* x) { asm volatile("" : "+s"(x)); return x; }
template <class T> DI T* lauv(T* x) { asm volatile("" : "+v"(x)); return x; }
DI int tidx(int wv) {
  int w = wv;
  asm volatile("" : "+s"(w));
  int l = (int)__builtin_amdgcn_mbcnt_hi(~0u, __builtin_amdgcn_mbcnt_lo(~0u, 0u));
  asm volatile("" : "+v"(l));
  return (w << 6) | l;
}
DI int lane_now() { int l = (int)__builtin_amdgcn_mbcnt_hi(~0u, __builtin_amdgcn_mbcnt_lo(~0u, 0u)); asm volatile("" : "+v"(l)); return l; }
DI float shx(float v, int m) { return __int_as_float(__builtin_amdgcn_ds_bpermute((lane_now() ^ m) << 2, __float_as_int(v))); }
DI int shx(int v, int m) { return __builtin_amdgcn_ds_bpermute((lane_now() ^ m) << 2, v); }
DI float shidx(float v, int src) { return __int_as_float(__builtin_amdgcn_ds_bpermute(src << 2, __float_as_int(v))); }
DI int shidx(int v, int src) { return __builtin_amdgcn_ds_bpermute(src << 2, v); }
DI int shdown(int v, int d) { const int l = lane_now(); return __builtin_amdgcn_ds_bpermute((l + d < 64 ? l + d : l) << 2, v); }
DI float shup(float v, int d) { const int l = lane_now(); return __int_as_float(__builtin_amdgcn_ds_bpermute((l - d >= 0 ? l - d : l) << 2, __float_as_int(v))); }
typedef float f32x2_t __attribute__((ext_vector_type(2)));
typedef __bf16 bf16x2_t __attribute__((ext_vector_type(2)));
DI unsigned pk2bf(float lo, float hi) { const f32x2_t v = {lo, hi}; return __builtin_bit_cast(unsigned, __builtin_convertvector(v, bf16x2_t)); }
DI u16 f2bf(float x) { return (u16)(pk2bf(x, 0.f) & 0xffffu); }
DI float bf2f(u16 v) { return __uint_as_float(((unsigned)v) << 16); }
DI float bfs(short v) { return __uint_as_float(((unsigned)(u16)v) << 16); }
DI int crow(int i, int h) { return (i & 3) + 8 * (i >> 2) + 4 * h; }
DI int kpos(int d) { int e = d & 15; return (d & ~15) + ((e >> 2) & 1) * 8 + (e >> 3) * 4 + (e & 3); }
DI bf16x8 pack8(const f32x16& x, int s) {
  typedef unsigned u32x4_t __attribute__((ext_vector_type(4)));
  u32x4_t r;
  r[0] = pk2bf(x[8 * s + 0], x[8 * s + 1]); r[1] = pk2bf(x[8 * s + 2], x[8 * s + 3]);
  r[2] = pk2bf(x[8 * s + 4], x[8 * s + 5]); r[3] = pk2bf(x[8 * s + 6], x[8 * s + 7]);
  return __builtin_bit_cast(bf16x8, r);
}
DI f32x16 zero16() { f32x16 z;
#pragma unroll
  for (int i = 0; i < 16; ++i) z[i] = 0.f; return z; }
DI bf16x8 zero8() { int zz = 0; asm volatile("" : "+v"(zz)); bf16x8 z;
#pragma unroll
  for (int i = 0; i < 8; ++i) z[i] = (short)zz; return z; }
DI int t5_bucket(int dist) {
  if (dist < 16) return dist;
  float lp = logf((float)dist / 16.0f) / 4.852030263919617f * 16.0f;
  int b = 16 + (int)lp;
  return b < 31 ? b : 31;
}

namespace pg8 {
#define PG8_LAS __attribute__((address_space(3)))
typedef unsigned short bf16_t;
typedef short bf16x8 __attribute__((ext_vector_type(8)));
typedef float f32x4 __attribute__((ext_vector_type(4)));
typedef unsigned u32x4 __attribute__((ext_vector_type(4)));
constexpr int BM = 256, BK = 64, HALF = 128, HTB = HALF * BK * 2  , STAGE_BYTES = 8 * HTB, NXCD = 8, WGM = 8;

__host__ __device__ __forceinline__ int lds_byte(int r, int c) { const int st = (r >> 4) * 2 + (c >> 5), rr = r & 15, cc = c & 31, ob = rr * 64 + cc * 2; return st * 1024 + (ob ^ (((ob >> 9) & 1) << 5)); }
__host__ __device__ __forceinline__ void stage_rc(int b, int& R, int& C) { const int st = b / 1024, sb = b % 1024, swz = sb ^ (((sb >> 9) & 1) << 5); R = (st >> 1) * 16 + swz / 64; C = (st & 1) * 32 + (swz % 64) / 2; }
__host__ __device__ __forceinline__ int perm32(int rho) { const int n = rho >> 4, i = rho & 15; return 8 * (i >> 2) + 4 * n + (i & 3); }

struct Unit { int pm, pn; };
struct Gemm { const bf16_t* A; const bf16_t* Bt; int M, N, K; int half; };
__device__ __forceinline__ size_t a_tile_row(const Gemm& g, int pm) { return g.half < 0 ? (size_t)pm * 256 : (size_t)(pm >> 3) * 4096 + (size_t)g.half * 2048 + (size_t)(pm & 7) * 256; }

struct StaticOrder {
    int nM, nN, nwg, G, c;
    __host__ __device__ void init(int M, int N, int G_, int c_) { nM = M / BM; nN = N / BM; nwg = nM * nN; G = G_; c = c_; }
    __host__ __device__ bool next(int i, Unit& u) const {
        const long L = (long)i * G + c; if (L >= nwg) return false;
        int wgid = (int)L; { const int q = nwg / NXCD, r = nwg % NXCD, xcd = wgid % NXCD, off = wgid / NXCD; wgid = (xcd < r ? xcd * (q + 1) : r * (q + 1) + (xcd - r) * q) + off; }
        const int nig = WGM * nN, gid = wgid / nig, fm = gid * WGM, gsz = (nM - fm) < WGM ? (nM - fm) : WGM;
        u.pm = fm + ((wgid % nig) % gsz); u.pn = (wgid % nig) / gsz; return true;
    }
    __device__ __forceinline__ void a_ready(const Unit&) const {}
    __device__ __forceinline__ void done(const Unit&) const {}
};
__device__ __forceinline__ unsigned cvt_pk_bf16(float lo, float hi) { unsigned r; asm volatile("v_cvt_pk_bf16_f32 %0, %1, %2" : "=v"(r) : "v"(lo), "v"(hi)); return r; }
template <class Epi, class Sched>
__device__ __forceinline__ void gemm_phase(PG8_LAS unsigned char* lds, const Gemm g, const Sched& S, const Epi& E, const int tid) {
    const int wid = __builtin_amdgcn_readfirstlane(tid >> 6), lane = tid & 63, wr = wid >> 2, wc = wid & 3, fr = lane & 15, fq = lane >> 4;
    const int K = g.K, nt = K / BK;
    unsigned voffA[2], voffB[2];
#pragma unroll
    for (int i = 0; i < 2; ++i) { int R, C; stage_rc(tid * 16 + i * 8192, R, C); const int Rb = Epi::PERM ? ((R & ~31) + perm32(R & 31)) : R;
        voffA[i] = (unsigned)(R * K + C) * 2u; voffB[i] = (unsigned)(Rb * K + C) * 2u; }
    const size_t kstep = (size_t)(BK * 2);
    const size_t hstep = (size_t)HALF * K * 2;
    const size_t tstep = 2 * hstep;
    const unsigned ldsw = (unsigned)wid * 1024u;
    const int aoff = lds_byte(wr * 64 + fr, fq * 8), boff = lds_byte(wc * 32 + fr, fq * 8);
#define PG8_SA(b, h) (((b) * 2 + (h)) * HTB)
#define PG8_SB(b, h) ((4 + (b) * 2 + (h)) * HTB)
#define PG8_STAGE(bufoff, gbase, voff) do { _Pragma("unroll") for (int _i = 0; _i < 2; ++_i) \
        __builtin_amdgcn_global_load_lds((const unsigned*)((const char*)(gbase) + (voff)[_i]), (PG8_LAS unsigned*)(lds + (bufoff) + ldsw + _i * 8192), 16, 0, 0); } while (0)
#define PG8_LDA(dst, b, h) do { _Pragma("unroll") for (int m = 0; m < 4; ++m) _Pragma("unroll") for (int k = 0; k < 2; ++k) dst[m][k] = *(const PG8_LAS bf16x8*)(lds + PG8_SA(b, h) + aoff + m * 2048 + k * 1024); } while (0)
#define PG8_LDB(dst, b, h) do { _Pragma("unroll") for (int n = 0; n < 2; ++n) _Pragma("unroll") for (int k = 0; k < 2; ++k) dst[n][k] = *(const PG8_LAS bf16x8*)(lds + PG8_SB(b, h) + boff + n * 2048 + k * 1024); } while (0)
#define PG8_MMA(ai, bj, At, Bt) do { __builtin_amdgcn_s_setprio(1); _Pragma("unroll") for (int m = 0; m < 4; ++m) _Pragma("unroll") for (int n = 0; n < 2; ++n) _Pragma("unroll") for (int k = 0; k < 2; ++k) \
        acc[ai][bj][m][n] = __builtin_amdgcn_mfma_f32_16x16x32_bf16(Bt[n][k], At[m][k], acc[ai][bj][m][n], 0, 0, 0); __builtin_amdgcn_s_setprio(0); } while (0)
#define PG8_WAIT_V(n) asm volatile("s_waitcnt vmcnt(" #n ")" ::: "memory")
#define PG8_WAIT_L(n) asm volatile("s_waitcnt lgkmcnt(" #n ")" ::: "memory")
#define PG8_BAR __builtin_amdgcn_s_barrier()
#define PG8_SCHED __builtin_amdgcn_sched_barrier(0)
    Unit cur, nxt; int ui = 0;
    if (!S.next(0, cur)) return;
    f32x4 acc[2][2][4][2];
#pragma unroll
    for (int a = 0; a < 2; ++a)
#pragma unroll
        for (int b = 0; b < 2; ++b)
#pragma unroll
            for (int m = 0; m < 4; ++m)
#pragma unroll
                for (int n = 0; n < 2; ++n) acc[a][b][m][n] = (f32x4){0.f, 0.f, 0.f, 0.f};
    bf16x8 At[4][2], B0[2][2], B1[2][2];
    const char* cA = (const char*)g.A + a_tile_row(g, cur.pm) * (size_t)K * 2; const char* cB = (const char*)g.Bt + (size_t)cur.pn * tstep;
    S.a_ready(cur);
    PG8_STAGE(PG8_SB(0, 0), cB, voffB); PG8_STAGE(PG8_SA(0, 0), cA, voffA); PG8_STAGE(PG8_SB(0, 1), cB + hstep, voffB); PG8_STAGE(PG8_SA(0, 1), cA + hstep, voffA);
    if (wr == 1) PG8_BAR;
    PG8_WAIT_V(4); PG8_BAR;
    PG8_STAGE(PG8_SB(1, 0), cB + kstep, voffB); PG8_STAGE(PG8_SA(1, 0), cA + kstep, voffA); PG8_STAGE(PG8_SB(1, 1), cB + hstep + kstep, voffB);
    PG8_WAIT_V(6); PG8_BAR;
    for (;;) {
        const bool has_next = S.next(ui + 1, nxt);
        const char* nA = has_next ? (const char*)g.A + a_tile_row(g, nxt.pm) * (size_t)K * 2 : cA; const char* nB = has_next ? (const char*)g.Bt + (size_t)nxt.pn * tstep : cB;
        for (int t = 0; t < nt; t += 2) {
            const bool last = (t == nt - 2);
            const char* a1 = cA + (size_t)(t + 1) * kstep;
            const char* a2 = last ? nA : cA + (size_t)(t + 2) * kstep; const char* b2 = last ? nB : cB + (size_t)(t + 2) * kstep;
            const char* a3 = a2 + kstep; const char* b3 = b2 + kstep;
            if (last && has_next) S.a_ready(nxt);
            PG8_LDB(B0, 0, 0); PG8_SCHED; PG8_LDA(At, 0, 0); PG8_STAGE(PG8_SA(1, 1), a1 + hstep, voffA);
            PG8_WAIT_L(8); PG8_BAR; PG8_WAIT_L(0); PG8_MMA(0, 0, At, B0); PG8_BAR; PG8_SCHED;
            PG8_LDB(B1, 0, 1); PG8_STAGE(PG8_SB(0, 0), b2, voffB);
            PG8_BAR; PG8_WAIT_L(0); PG8_MMA(0, 1, At, B1); PG8_BAR;
            PG8_LDA(At, 0, 1); PG8_STAGE(PG8_SA(0, 0), a2, voffA);
            PG8_BAR; PG8_WAIT_L(0); PG8_MMA(1, 0, At, B0); PG8_BAR; PG8_SCHED;
            PG8_STAGE(PG8_SB(0, 1), b2 + hstep, voffB);
            PG8_WAIT_V(6); PG8_BAR; PG8_MMA(1, 1, At, B1); PG8_BAR;
            PG8_LDB(B0, 1, 0); PG8_SCHED; PG8_LDA(At, 1, 0); PG8_STAGE(PG8_SA(0, 1), a2 + hstep, voffA);
            PG8_WAIT_L(8); PG8_BAR; PG8_WAIT_L(0); PG8_MMA(0, 0, At, B0); PG8_BAR; PG8_SCHED;
            PG8_LDB(B1, 1, 1); PG8_STAGE(PG8_SB(1, 0), b3, voffB);
            PG8_BAR; PG8_WAIT_L(0); PG8_MMA(0, 1, At, B1); PG8_BAR;
            PG8_LDA(At, 1, 1); PG8_STAGE(PG8_SA(1, 0), a3, voffA);
            PG8_BAR; PG8_WAIT_L(0); PG8_MMA(1, 0, At, B0); PG8_BAR; PG8_SCHED;
            PG8_STAGE(PG8_SB(1, 1), b3 + hstep, voffB);
            PG8_WAIT_V(6); PG8_BAR; PG8_MMA(1, 1, At, B1); PG8_BAR;
        }
        if constexpr (!Epi::AFTER_DRAIN) { E(acc, cur, wr, wc, fr, fq); S.done(cur); }
        if (!has_next) break;
#pragma unroll
        for (int a = 0; a < 2; ++a)
#pragma unroll
            for (int b = 0; b < 2; ++b)
#pragma unroll
                for (int m = 0; m < 4; ++m)
#pragma unroll
                    for (int n = 0; n < 2; ++n) acc[a][b][m][n] = (f32x4){0.f, 0.f, 0.f, 0.f};
        cur = nxt; cA = nA; cB = nB; ++ui;
    }
    PG8_WAIT_V(0);
    if (wr == 0) PG8_BAR;
    PG8_BAR;
    if constexpr (Epi::AFTER_DRAIN) { E.fused(acc, cur, wr, wc, fr, fq, lds, wid, lane); S.done(cur); }
#undef PG8_SA
#undef PG8_SB
#undef PG8_STAGE
#undef PG8_LDA
#undef PG8_LDB
#undef PG8_MMA
#undef PG8_WAIT_V
#undef PG8_WAIT_L
#undef PG8_BAR
#undef PG8_SCHED
}
}


namespace pg8 {
template <int ACT> struct EpiB16 {
    static constexpr bool PERM = true, AFTER_DRAIN = false;
    bf16_t* O; int ldc;
    __device__ __forceinline__ void operator()(const f32x4 (&acc)[2][2][4][2], const Unit& u, int wr, int wc, int fr, int fq) const {
        const int row0 = u.pm * BM + wr * 64 + fr, col0 = u.pn * BM + wc * 32 + 8 * fq;
#pragma unroll
        for (int ai = 0; ai < 2; ++ai)
#pragma unroll
            for (int m = 0; m < 4; ++m) { bf16_t* rowp = O + (size_t)(row0 + ai * HALF + m * 16) * ldc + col0;
#pragma unroll
                for (int bj = 0; bj < 2; ++bj) { f32x4 v0 = acc[ai][bj][m][0], v1 = acc[ai][bj][m][1];
                    if (ACT == 1) {
#pragma unroll
                        for (int j = 0; j < 4; ++j) { float a = v0[j] > 0.f ? v0[j] : 0.f, b = v1[j] > 0.f ? v1[j] : 0.f; v0[j] = a * a; v1[j] = b * b; } }
                    u32x4 w; w.x = cvt_pk_bf16(v0[0], v0[1]); w.y = cvt_pk_bf16(v0[2], v0[3]); w.z = cvt_pk_bf16(v1[0], v1[1]); w.w = cvt_pk_bf16(v1[2], v1[3]);
                    *(u32x4*)(rowp + bj * HALF) = w; } }
    }
};
struct EpiB16HN {
    static constexpr bool PERM = true, AFTER_DRAIN = false;
    bf16_t* O; int ldc; int ncols_norm, nq_cols; const float* gq; const float* gk; PG8_LAS float* T;
    __device__ __forceinline__ void operator()(const f32x4 (&acc)[2][2][4][2], const Unit& u, int wr, int wc, int fr, int fq) const {
        const int row0 = u.pm * BM + wr * 64 + fr, col0 = u.pn * BM + wc * 32 + 8 * fq;
        const bool hn = u.pn * BM < ncols_norm;
        float part[2][4][2];
        if (hn) {
#pragma unroll
            for (int ai = 0; ai < 2; ++ai)
#pragma unroll
                for (int m = 0; m < 4; ++m)
#pragma unroll
                    for (int bj = 0; bj < 2; ++bj) { const f32x4 a = acc[ai][bj][m][0], b = acc[ai][bj][m][1];
                        float sq = a[0] * a[0] + a[1] * a[1] + a[2] * a[2] + a[3] * a[3] + b[0] * b[0] + b[1] * b[1] + b[2] * b[2] + b[3] * b[3];
                        sq += shx(sq, 16); sq += shx(sq, 32); part[ai][m][bj] = sq; }
            PG8_LAS float* mine = T + ((wr * 4 + wc) * 16) * 16 + fr;
            if (fq == 0) {
#pragma unroll
                for (int ai = 0; ai < 2; ++ai)
#pragma unroll
                    for (int m = 0; m < 4; ++m)
#pragma unroll
                        for (int bj = 0; bj < 2; ++bj) mine[((ai * 4 + m) * 2 + bj) * 16] = part[ai][m][bj];
            }
            asm volatile("s_waitcnt lgkmcnt(0)" ::: "memory");
            __builtin_amdgcn_s_barrier();
            const PG8_LAS float* other = T + ((wr * 4 + (wc ^ 1)) * 16) * 16 + fr;
#pragma unroll
            for (int ai = 0; ai < 2; ++ai)
#pragma unroll
                for (int m = 0; m < 4; ++m)
#pragma unroll
                    for (int bj = 0; bj < 2; ++bj) part[ai][m][bj] += other[((ai * 4 + m) * 2 + bj) * 16];
        }
        const bool isq = u.pn * BM < nq_cols;
        const float* gp = (isq ? gq : gk) + ((wc & 1) * 32 + 8 * fq);
        const float qs = isq ? 0.125f * 1.4426950408889634f : 1.0f;
        float g8[8];
#pragma unroll
        for (int j = 0; j < 8; ++j) g8[j] = hn ? gp[j] * qs : 1.0f;
#pragma unroll
        for (int ai = 0; ai < 2; ++ai)
#pragma unroll
            for (int m = 0; m < 4; ++m) { bf16_t* rowp = O + (size_t)(row0 + ai * HALF + m * 16) * ldc + col0;
#pragma unroll
                for (int bj = 0; bj < 2; ++bj) { f32x4 v0 = acc[ai][bj][m][0], v1 = acc[ai][bj][m][1];
                    const float r = hn ? rsqrtf(part[ai][m][bj] * (1.0f / 64.0f) + 1e-6f) : 1.0f;
#pragma unroll
                    for (int j = 0; j < 4; ++j) { v0[j] *= r * g8[j]; v1[j] *= r * g8[4 + j]; }
                    u32x4 w; w.x = cvt_pk_bf16(v0[0], v0[1]); w.y = cvt_pk_bf16(v0[2], v0[3]); w.z = cvt_pk_bf16(v1[0], v1[1]); w.w = cvt_pk_bf16(v1[2], v1[3]);
                    *(u32x4*)(rowp + bj * HALF) = w; } }
    }
};
struct EpiResid {
    static constexpr bool PERM = false, AFTER_DRAIN = false;
    float* C; const float* X;
    __device__ __forceinline__ void operator()(const f32x4 (&acc)[2][2][4][2], const Unit& u, int wr, int wc, int fr, int fq) const {
        const int row0 = u.pm * BM + wr * 64 + fr, col0 = u.pn * BM + wc * 32 + 4 * fq;
#pragma unroll
        for (int ai = 0; ai < 2; ++ai) {
            f32x4 xv[4][2][2];
#pragma unroll
            for (int m = 0; m < 4; ++m)
#pragma unroll
                for (int bj = 0; bj < 2; ++bj)
#pragma unroll
                    for (int n = 0; n < 2; ++n) xv[m][bj][n] = *(const f32x4*)(X + (size_t)(row0 + ai * HALF + m * 16) * 1024 + col0 + bj * HALF + n * 16);
#pragma unroll
            for (int m = 0; m < 4; ++m)
#pragma unroll
                for (int bj = 0; bj < 2; ++bj)
#pragma unroll
                    for (int n = 0; n < 2; ++n) *(f32x4*)(C + (size_t)(row0 + ai * HALF + m * 16) * 1024 + col0 + bj * HALF + n * 16) = xv[m][bj][n] + acc[ai][bj][m][n];
        }
    }
};
struct EpiCIn {
    static constexpr bool PERM = true, AFTER_DRAIN = false;
    bf16_t* Q; bf16_t* G; float* S; int half;
    __device__ __forceinline__ void operator()(const f32x4 (&acc)[2][2][4][2], const Unit& u, int wr, int wc, int fr, int fq) const {
        const int rl0 = wr * 64 + fr, cl0 = wc * 32 + 8 * fq;
        const size_t crow0 = (size_t)u.pm * 256, arow0 = (size_t)(u.pm >> 3) * 4096 + (size_t)half * 2048 + (size_t)(u.pm & 7) * 256;
#pragma unroll
        for (int ai = 0; ai < 2; ++ai)
#pragma unroll
            for (int m = 0; m < 4; ++m) { const int rl = rl0 + ai * HALF + m * 16;
#pragma unroll
                for (int bj = 0; bj < 2; ++bj) { const f32x4 v0 = acc[ai][bj][m][0], v1 = acc[ai][bj][m][1]; const int cl = cl0 + bj * HALF;
                    if (u.pn < 16) {
                        u32x4 w; w.x = cvt_pk_bf16(v0[0], v0[1]); w.y = cvt_pk_bf16(v0[2], v0[3]); w.z = cvt_pk_bf16(v1[0], v1[1]); w.w = cvt_pk_bf16(v1[2], v1[3]);
                        if (u.pn < 12) *(u32x4*)(Q + (crow0 + rl) * 3072 + u.pn * 256 + cl) = w;
                        else *(u32x4*)(G + (arow0 + rl) * 1024 + (u.pn - 12) * 256 + cl) = w;
                    } else if (cl < 16) { float* sp = S + (arow0 + rl) * 16 + cl; *(f32x4*)sp = v0; *(f32x4*)(sp + 4) = v1; } } }
    }
};
}

struct CvtTile { const float* src; int K, N, k0, n0; unsigned off; };
DI CvtTile cvt_locate(const Ctx& p, int t) {
  int K = cK[0], N = cN[0], base = 0; unsigned off = 0, soff = 0; int bi = 0;
#define WSEL(i) if (t >= wTileStart(i)) { K = cK[i]; N = cN[i]; base = wTileStart(i); off = wOff(i); soff = cSrcOff[i]; bi = cBase[i]; }
  WSEL(1) WSEL(2) WSEL(3) WSEL(4) WSEL(5) WSEL(6) WSEL(7) WSEL(8) WSEL(9) WSEL(10) WSEL(11) WSEL(12) WSEL(13) WSEL(14) WSEL(15)
#undef WSEL
  const float* src = p.wbase[0];
#pragma unroll
  for (int q = 1; q < 8; ++q) if (bi == q) src = p.wbase[q];
  const int lt = t - base, nkt = K / 64;
  CvtTile c; c.src = src + soff; c.K = K; c.N = N; c.k0 = (lt % nkt) * 64; c.n0 = (lt / nkt) * 64; c.off = off;
  return c;
}
DI void phase_convert(int wv_, int vb_, int nvb_, char* ws_, const Ctx& p, char* smem) {
  float* tile = (float*)smem;
  const int tid = tidx(wv_);
  const int ty = tid >> 4, tx = tid & 15;
  constexpr int total = wTileStart(16);
  const int trips_ = (total + nvb_ - 1) / nvb_;
#define CVT_LOAD(C, V) { _Pragma("unroll") for (int i = 0; i < 4; ++i) { const int n_ = (C).n0 + tx * 4; \
    V[i] = (n_ < (C).N) ? *(const float4*)((C).src + (size_t)((C).k0 + ty + 16 * i) * (C).N + n_) : make_float4(0.f, 0.f, 0.f, 0.f); } }
  CvtTile cur = cvt_locate(p, (vb_ < total) ? vb_ : total - 1);
  float4 v[4];
  CVT_LOAD(cur, v)
  for (int k_ = 0; k_ < trips_; ++k_) {
    const int tn = vb_ + (k_ + 1) * nvb_;
    const CvtTile nxt = cvt_locate(p, (tn < total) ? tn : total - 1);
    float4 vn[4];
    CVT_LOAD(nxt, vn)
#pragma unroll
    for (int i = 0; i < 4; ++i) { float* d = tile + (ty + 16 * i) * 65 + tx * 4; d[0] = v[i].x; d[1] = v[i].y; d[2] = v[i].z; d[3] = v[i].w; }
    __syncthreads();
    {
      const int n = tid >> 2, kq = tid & 3;
      bf16x8 o0, o1;
#pragma unroll
      for (int j = 0; j < 8; ++j) { o0[j] = (short)f2bf(tile[(kq * 16 + j) * 65 + n]); o1[j] = (short)f2bf(tile[(kq * 16 + 8 + j) * 65 + n]); }
      u16* dst = (u16*)(ws_ + WS_WT) + (size_t)cur.off + (size_t)(cur.n0 + n) * cur.K + cur.k0 + kq * 16;
      *(bf16x8*)dst = o0; *(bf16x8*)(dst + 8) = o1;
    }
    __syncthreads();
    cur = nxt;
#pragma unroll
    for (int i = 0; i < 4; ++i) v[i] = vn[i];
  }
#undef CVT_LOAD
}

DI void phase_norm(int wv_, int vb_, int nvb_, const float* x, const float* gain, u16* H) {
  const int tid = tidx(wv_); const int lane = tid & 63, wave = tid >> 6;
  float4 g[4];
#pragma unroll
  for (int c = 0; c < 4; ++c) g[c] = ((const float4*)gain)[c * 64 + lane];
  for (int row0 = (vb_ * 4 + wave) * 4; row0 < NTOK; row0 += nvb_ * 16) {
    float4 v[4][4]; float ss[4];
#pragma unroll
    for (int r = 0; r < 4; ++r) {
      const float4* xr = (const float4*)(x + (size_t)(row0 + r) * DM);
#pragma unroll
      for (int c = 0; c < 4; ++c) v[r][c] = xr[c * 64 + lane];
    }
#pragma unroll
    for (int r = 0; r < 4; ++r) { float a = 0.f;
#pragma unroll
      for (int c = 0; c < 4; ++c) a += v[r][c].x * v[r][c].x + v[r][c].y * v[r][c].y + v[r][c].z * v[r][c].z + v[r][c].w * v[r][c].w;
      ss[r] = a; }
#pragma unroll
    for (int o = 1; o < 64; o <<= 1) {
#pragma unroll
      for (int r = 0; r < 4; ++r) ss[r] += shx(ss[r], o);
    }
#pragma unroll
    for (int r = 0; r < 4; ++r) {
      const float rr = rsqrtf(ss[r] * (1.0f / DM) + 1e-6f);
#pragma unroll
      for (int c = 0; c < 4; ++c) {
        s16x4 o; o[0] = (short)f2bf(v[r][c].x * rr * g[c].x); o[1] = (short)f2bf(v[r][c].y * rr * g[c].y); o[2] = (short)f2bf(v[r][c].z * rr * g[c].z); o[3] = (short)f2bf(v[r][c].w * rr * g[c].w);
        *(s16x4*)(H + (size_t)(row0 + r) * DM + (c * 64 + lane) * 4) = o;
      }
    }
  }
}

DI void phase_headnorm(int wv_, int vb_, int nvb_, u16* P, int ld, int nheads, int nq, const float* gq, const float* gk) {
  const int tid = tidx(wv_);
  const int part = tid & 7;
  const size_t total = (size_t)NTOK * nheads * 8;
  for (size_t idx = (size_t)vb_ * 256 + tid; idx < total; idx += (size_t)nvb_ * 256) {
    const size_t rh = idx >> 3; const size_t row = rh / nheads; const int head = (int)(rh - row * nheads);
    u16* pp = P + row * ld + head * 64 + part * 8;
    bf16x8 v = *(const bf16x8*)pp;
    float f[8]; float ss = 0.f;
#pragma unroll
    for (int j = 0; j < 8; ++j) { f[j] = bfs(v[j]); ss += f[j] * f[j]; }
    ss += shx(ss, 1); ss += shx(ss, 2); ss += shx(ss, 4);
    const float rn = rsqrtf(ss * (1.0f / 64.0f) + 1e-6f) * (head < nq ? 0.125f : 1.0f);
    const float* g = (head < nq ? gq : gk) + part * 8;
    bf16x8 o;
#pragma unroll
    for (int j = 0; j < 8; ++j) o[j] = (short)f2bf(f[j] * rn * g[j]);
    *(bf16x8*)pp = o;
  }
}

DI void phase_attn_a(int wv_, int vb_, int nvb_, char* ws_, const Ctx& p, char* smem) {
  u16* Vt = (u16*)smem;
  float* sBias = (float*)(smem + 64 * 260 * 2);
  const u16* P = (const u16*)(ws_ + WS_P);
  const int tid = tidx(wv_), lane = tid & 63, wave = tid >> 6, c = lane & 31, h = lane >> 5;
  for (int k_ = 0; k_ < (6144 + nvb_ - 1) / nvb_; ++k_) {
    const int u = (vb_ + k_ * nvb_ < 6144) ? vb_ + k_ * nvb_ : 6143;
    const int head = u & 7, g = (u >> 3) % 3, rest = u / 24, idx = rest & 31, b = rest >> 5;
    const int dil = (g == 0) ? 1 : ((g == 1) ? 4 : 16);
    const int nbper = 32 / dil, r = idx / nbper, nb = idx % nbper;
    u16* Og = (g == 0) ? (u16*)(ws_ + WS_H) : ((g == 1) ? (u16*)(ws_ + WS_H + 32 * MiB) : (u16*)(ws_ + WS_E));
    float* lse = (float*)(ws_ + WS_LSE) + (size_t)g * NTOK * 8;
    if (tid <= 128) sBias[tid] = p.rel_bias[t5_bucket(tid * dil) * 40 + g * 8 + head] * 1.4426950408889634f;
    {
      const int kk = tid; const int ksub = nb * 128 - 128 + kk;
      bf16x8 v[8];
      if (ksub >= 0) {
        const u16* vp = P + ((size_t)b * SEQ + (size_t)ksub * dil + r) * 4608 + 3072 + g * 512 + head * 64;
#pragma unroll
        for (int i = 0; i < 8; ++i) v[i] = *(const bf16x8*)(vp + i * 8);
      } else {
#pragma unroll
        for (int i = 0; i < 8; ++i) v[i] = zero8();
      }
#pragma unroll
      for (int i = 0; i < 8; ++i)
#pragma unroll
        for (int jj = 0; jj < 8; ++jj) Vt[(i * 8 + jj) * 260 + kk] = (u16)v[i][jj];
    }
    __syncthreads();
    {
      const int qi = 32 * wave + c;
      const int qtok = (nb * 128 + qi) * dil + r;
      const u16* qp = P + ((size_t)b * SEQ + qtok) * 4608 + g * 512 + head * 64;
      bf16x8 qf[4];
#pragma unroll
      for (int ks = 0; ks < 4; ++ks) qf[ks] = *(const bf16x8*)(qp + ks * 16 + h * 8);
      float mx = -INFINITY, sum = 0.f;
      f32x16 oacc[2]; oacc[0] = zero16(); oacc[1] = zero16();
#pragma unroll 1
      for (int kb = 0; kb < 5; ++kb) {
        const int kk = 32 * wave + 32 * kb + c; const int ksub0 = nb * 128 - 128 + kk;
        bf16x8 kf[4];
        if (ksub0 >= 0) {
          const u16* kp = P + ((size_t)b * SEQ + (size_t)ksub0 * dil + r) * 4608 + 1536 + g * 512 + head * 64;
#pragma unroll
          for (int ks = 0; ks < 4; ++ks) kf[ks] = *(const bf16x8*)(kp + ks * 16 + h * 8);
        } else {
#pragma unroll
          for (int ks = 0; ks < 4; ++ks) kf[ks] = zero8();
        }
        f32x16 sa = zero16();
#pragma unroll
        for (int ks = 0; ks < 4; ++ks) sa = MFMA32(kf[ks], qf[ks], sa);
        float bm = -INFINITY;
        const int sbase = c + 128 - 32 * kb - 4 * h;
        const unsigned slim = (unsigned)((nb * 128 + 32 * wave + c) < 128 ? (nb * 128 + 32 * wave + c) : 128);
#pragma unroll
        for (int i = 0; i < 16; ++i) {
          const int step = sbase - ((i & 3) + 8 * (i >> 2));
          const bool valid = (unsigned)step <= slim;
          const float bv = sBias[step];
          float v = valid ? sa[i] + bv : -INFINITY;
          sa[i] = v; bm = fmaxf(bm, v);
        }
        bm = fmaxf(bm, shx(bm, 32));
        const float mnew = fmaxf(mx, bm);
        const float mref = (mnew == -INFINITY) ? 0.f : mnew;
        const float scale = __builtin_amdgcn_exp2f(mx - mref);
        float ps = 0.f;
#pragma unroll
        for (int i = 0; i < 16; ++i) { float pv = __builtin_amdgcn_exp2f(sa[i] - mref); sa[i] = pv; ps += pv; }
        sum = sum * scale + ps; mx = mnew;
#pragma unroll
        for (int i = 0; i < 16; ++i) { oacc[0][i] *= scale; oacc[1][i] *= scale; }
#pragma unroll
        for (int s = 0; s < 2; ++s) {
          bf16x8 pb = pack8(sa, s);
          const int keybase = 32 * wave + 32 * kb + 16 * s;
#pragma unroll
          for (int mb = 0; mb < 2; ++mb) {
            const u16* vr = Vt + (mb * 32 + c) * 260 + keybase + 4 * h;
            s16x4 lo = *(const s16x4*)vr, hi = *(const s16x4*)(vr + 8);
            bf16x8 va = __builtin_shufflevector(lo, hi, 0, 1, 2, 3, 4, 5, 6, 7);
            oacc[mb] = MFMA32(va, pb, oacc[mb]);
          }
        }
      }
      sum += shx(sum, 32);
      const float inv = 1.0f / sum;
      u16* op = Og + ((size_t)b * SEQ + qtok) * 512 + head * 64;
#pragma unroll
      for (int mb = 0; mb < 2; ++mb)
#pragma unroll
        for (int ig = 0; ig < 4; ++ig) {
          s16x4 o;
#pragma unroll
          for (int q = 0; q < 4; ++q) o[q] = (short)f2bf(oacc[mb][ig * 4 + q] * inv);
          *(s16x4*)(op + mb * 32 + 8 * ig + 4 * h) = o;
        }
      if (h == 0) lse[((size_t)b * SEQ + qtok) * 8 + head] = (mx + log2f(sum)) * 0.6931471805599453f;
    }
    __syncthreads();
  }
}

DI void phase_combine_a(int wv_, int vb_, int nvb_, char* ws_, const Ctx& p) {
  u16* O0 = (u16*)(ws_ + WS_H); const u16* O1 = (const u16*)(ws_ + WS_H + 32 * MiB); const u16* O2 = (const u16*)(ws_ + WS_E);
  const float* lse = (const float*)(ws_ + WS_LSE);
  const int tid = tidx(wv_);
  const size_t stride = (size_t)nvb_ * 256, total = (size_t)NTOK * 64;
  for (size_t idx0 = (size_t)vb_ * 256 + tid; idx0 < total; idx0 += 4 * stride) {
    bf16x8 a[4], b[4], cc[4]; float l0[4], l1[4], l2[4]; bool ok[4];
#pragma unroll
    for (int q = 0; q < 4; ++q) {
      const size_t idx = idx0 + q * stride; ok[q] = idx < total; const size_t ix = ok[q] ? idx : idx0;
      const size_t tok = ix >> 6; const int head = (ix >> 3) & 7;
      l0[q] = lse[tok * 8 + head]; l1[q] = lse[(size_t)NTOK * 8 + tok * 8 + head]; l2[q] = lse[(size_t)2 * NTOK * 8 + tok * 8 + head];
      a[q] = *(const bf16x8*)(O0 + ix * 8); b[q] = *(const bf16x8*)(O1 + ix * 8); cc[q] = *(const bf16x8*)(O2 + ix * 8);
    }
#pragma unroll
    for (int q = 0; q < 4; ++q) {
      const float m = fmaxf(l0[q], fmaxf(l1[q], l2[q]));
      float e0 = __expf(l0[q] - m), e1 = __expf(l1[q] - m), e2 = __expf(l2[q] - m);
      const float inv = 1.0f / (e0 + e1 + e2); e0 *= inv; e1 *= inv; e2 *= inv;
      bf16x8 o;
#pragma unroll
      for (int j = 0; j < 8; ++j) o[j] = (short)f2bf(e0 * bfs(a[q][j]) + e1 * bfs(b[q][j]) + e2 * bfs(cc[q][j]));
      if (ok[q]) *(bf16x8*)(O0 + (idx0 + q * stride) * 8) = o;
    }
  }
}

DI unsigned hkey(float s) {
  if (s == 0.f) s = 0.f;
  const _Float16 hv = (_Float16)s;
  const unsigned u = (unsigned)__builtin_bit_cast(unsigned short, hv);
  return (u & 0x8000u) ? (~u & 0xffffu) : (u | 0x8000u);
}

DI void phase_mix_b(int wv_, int vb_, int nvb_, char* ws_, const Ctx& p, char* smem) {
  u16* sc = (u16*)smem;
  unsigned* hist = (unsigned*)(smem + 65536);
  u16* sel = (u16*)(smem + 65536 + 4096);
  const u16* P = (const u16*)(ws_ + WS_P);
  for (int k_ = 0; k_ < (4096 + nvb_ - 1) / nvb_; ++k_) {
    const int it = (vb_ + k_ * nvb_ < 4096) ? vb_ + k_ * nvb_ : 4095;
    const int b = it & 7, qt = 511 - (it >> 3), t0 = qt * 8;
    const u16* Pb = P + (size_t)b * SEQ * 2304;
    {
      const int tid1 = tidx(wv_); const int c = tid1 & 31, h = (tid1 >> 5) & 1, wave = tid1 >> 6;
      const int hd = (c & 3) + 4 * ((c >> 3) & 1), qq = ((c >> 2) & 1) + 2 * (c >> 4);
      bf16x8 qa[2][4];
      float wf[2][2][8];
#pragma unroll
      for (int rb = 0; rb < 2; ++rb) {
#pragma unroll
        for (int ks = 0; ks < 4; ++ks) qa[rb][ks] = *(const bf16x8*)(Pb + (size_t)(t0 + rb * 4 + qq) * 2304 + 1536 + hd * 64 + ks * 16 + h * 8);
#pragma unroll
        for (int q2 = 0; q2 < 2; ++q2) {
          const bf16x8 wv = *(const bf16x8*)(Pb + (size_t)(t0 + rb * 4 + h + 2 * q2) * 2304 + 2112);
#pragma unroll
          for (int j = 0; j < 8; ++j) wf[rb][q2][j] = (bfs(wv[j]) * 0.35355339059327373f) * 0.125f;
        }
      }
      const int nkb = (t0 + 7) / 32 + 1;
#pragma unroll 1
      for (int kb0 = 0; kb0 < nkb; kb0 += 16) {
        bf16x8 kf[4][4];
#pragma unroll
        for (int u = 0; u < 4; ++u) {
          const int kb = kb0 + wave + 4 * u; const int kbc = kb < 127 ? kb : 127;
          const u16* kp = Pb + (size_t)(kbc * 32 + c) * 2304 + 2048 + h * 8;
#pragma unroll
          for (int ks = 0; ks < 4; ++ks) kf[u][ks] = *(const bf16x8*)(kp + ks * 16);
        }
#pragma unroll
        for (int u = 0; u < 4; ++u) {
          const int key = (kb0 + wave + 4 * u) * 32 + c;
#pragma unroll
          for (int rb = 0; rb < 2; ++rb) {
            f32x16 acc = zero16();
#pragma unroll
            for (int ks = 0; ks < 4; ++ks) acc = MFMA32(qa[rb][ks], kf[u][ks], acc);
            float s0 = 0.f, s1 = 0.f;
#pragma unroll
            for (int i = 0; i < 8; ++i) {
              const int hh = (i & 3) + 4 * ((i >> 2) & 1);
              const float a0 = acc[i], a1 = acc[8 + i];
              s0 += wf[rb][0][hh] * (a0 > 0.f ? a0 : 0.f); s1 += wf[rb][1][hh] * (a1 > 0.f ? a1 : 0.f);
            }
            const int q0 = rb * 4 + h, q1 = rb * 4 + h + 2;
            if (key <= t0 + q0) sc[q0 * 4096 + key] = (u16)hkey(s0);
            if (key <= t0 + q1) sc[q1 * 4096 + key] = (u16)hkey(s1);
          }
        }
      }
    }
    __syncthreads();
#pragma unroll 1
    for (int qs = 0; qs < 2; ++qs) {
      const int tid2 = tidx(wv_); const int lane = tid2 & 63, wave = tid2 >> 6;
      const int qsel = wave + 4 * qs;
      const int t = t0 + qsel, n = t + 1;
      const u16* myS = sc + qsel * 4096;
      unsigned* myH = hist + wave * 256;
      unsigned prefix = 0; int need = 256;
#pragma unroll 1
      for (int pass = 0; pass < 2; ++pass) {
        const int shift = 8 - 8 * pass;
        *(uint4*)(myH + lane * 4) = make_uint4(0, 0, 0, 0);
        asm volatile("s_waitcnt lgkmcnt(0)" ::: "memory");
        for (int j8 = lane * 8; j8 < n; j8 += 512) {
          const bf16x8 kv = *(const bf16x8*)(myS + j8);
#pragma unroll
          for (int e = 0; e < 8; ++e) {
            const unsigned u = (unsigned)(u16)kv[e];
            const bool ok = (j8 + e < n) && ((pass == 0) ? true : ((u >> 8) == prefix));
            if (ok) atomicAdd(&myH[(u >> shift) & 255], 1u);
          }
        }
        asm volatile("s_waitcnt lgkmcnt(0)" ::: "memory");
        uint4 hv = *(const uint4*)(myH + lane * 4);
        int tot = (int)(hv.x + hv.y + hv.z + hv.w);
        int incl = tot;
#pragma unroll
        for (int off = 1; off < 64; off <<= 1) { int v = shdown(incl, off); if (lane + off < 64) incl += v; }
        int above = incl - tot;
        bool hit = (above < need) && (need <= incl);
        int bin = 0, nn = need;
        if (hit) {
          int a = above;
          if (need <= a + (int)hv.w) { bin = 3; nn = need - a; }
          else { a += hv.w; if (need <= a + (int)hv.z) { bin = 2; nn = need - a; }
            else { a += hv.z; if (need <= a + (int)hv.y) { bin = 1; nn = need - a; } else { a += hv.y; bin = 0; nn = need - a; } } }
          bin += lane * 4;
        }
        unsigned long long mk = __ballot(hit);
        int src = mk ? (__ffsll((long long)mk) - 1) : 0;
        bin = shidx(bin, src); nn = shidx(nn, src);
        prefix = (prefix << 8) | (unsigned)bin; need = nn;
      }
      u16* mySel = sel + wave * 256;
      int cnt = 0;
      if (n <= 256) {
        for (int j = lane; j < 256; j += 64) mySel[j] = (u16)((j < n) ? j : 0);
        cnt = n;
      } else {
        int eqseen = 0;
        const unsigned long long lt = (1ull << lane) - 1ull;
        for (int j0 = 0; j0 < n; j0 += 64) {
          const int j = j0 + lane; const bool v = j < n;
          unsigned u = v ? (unsigned)myS[j] : 0u;
          const bool gt = v && (u > prefix), eq = v && (u == prefix);
          unsigned long long be = __ballot(eq);
          const bool take = gt || (eq && (eqseen + __popcll(be & lt) < need));
          unsigned long long bt = __ballot(take);
          int pos = cnt + __popcll(bt & lt);
          if (take && pos < 256) mySel[pos] = (u16)j;
          cnt += __popcll(bt); eqseen += __popcll(be);
        }
        if (cnt > 256) cnt = 256;
      }
      asm volatile("s_waitcnt lgkmcnt(0)" ::: "memory");
      {
        u16* gsel = (u16*)(ws_ + WS_SEL) + ((size_t)b * SEQ + t) * 256;
        unsigned char* gselb = (unsigned char*)(ws_ + WS_SELB) + ((size_t)b * SEQ + t) * 256;
        for (int j = lane; j < 256; j += 64) {
          const int tk = (int)mySel[j];
          gsel[j] = (u16)tk;
          gselb[j] = (unsigned char)t5_bucket(t - tk > 0 ? t - tk : 0);
        }
        if (lane == 0) ((int*)(ws_ + WS_CNT))[(size_t)b * SEQ + t] = cnt;
      }
      asm volatile("s_waitcnt lgkmcnt(0)" ::: "memory");
    }
    __syncthreads();
  }
}

DI void phase_mix_b2(int wv_, int vb_, int nvb_, char* ws_, const Ctx& p, char* smem) {
  const u16* P = (const u16*)(ws_ + WS_P);
  u16* Y = (u16*)(ws_ + WS_H);
  float* sbias = (float*)(smem + 65536);
  u16* selL = (u16*)(smem + 65536 + 2048);
  unsigned char* selbL = (unsigned char*)(smem + 65536 + 2048 + 2048);
  {
    const int tid = tidx(wv_);
    for (int i = tid; i < 512; i += 256) sbias[i] = p.rel_bias[(i >> 4) * 40 + 24 + (i & 15)] * 1.4426950408889634f;
  }
  __syncthreads();
  for (int ib = vb_; ib < 32768; ib += nvb_) {
    const int tid = tidx(wv_); const int lane = tid & 63, wave = tid >> 6, n16 = tid & 15, fq = (tid >> 4) & 3;
    const int b = ib & 7, r4 = ib >> 3, hkv = r4 >> 10, t = (r4 & 1023) * 4 + wave;
    const u16* Pb = P + (size_t)b * SEQ * 2304;
    u16* mySel = selL + wave * 256;
    unsigned char* mySelb = selbL + wave * 256;
    const size_t qrow = (size_t)b * SEQ + t;
    const int cnt = ((const int*)(ws_ + WS_CNT))[qrow];
    asm volatile("s_waitcnt lgkmcnt(0)" ::: "memory");
    *(uint2*)(mySel + lane * 4) = *(const uint2*)((const u16*)(ws_ + WS_SEL) + qrow * 256 + lane * 4);
    *(unsigned*)(mySelb + lane * 4) = *(const unsigned*)((const unsigned char*)(ws_ + WS_SELB) + qrow * 256 + lane * 4);
    asm volatile("s_waitcnt lgkmcnt(0)" ::: "memory");
    bf16x8 qf[2];
    {
      const u16* qp = Pb + (size_t)t * 2304 + (hkv * 4 + (n16 & 3)) * 64 + fq * 8;
      qf[0] = *(const bf16x8*)qp; qf[1] = *(const bf16x8*)(qp + 32);
      if (n16 >= 4) { qf[0] = zero8(); qf[1] = zero8(); }
    }
    f32x4 lg[16];
    char* Ks = smem + wave * 16384;
    bf16x8 vreg[16];
#define LOADKV(BASECOL, SH) { _Pragma("unroll") for (int rr = 0; rr < 16; ++rr) { \
      const unsigned vo_ = (unsigned)mySel[(SH) * 128 + rr * 8 + (lane >> 3)] * 4608u + (unsigned)(hkv * 128 + (lane & 7) * 16); \
      vreg[rr] = *(const bf16x8*)((const char*)(Pb + (BASECOL)) + (size_t)vo_); } }
#define LOADV(SH) LOADKV(1280, SH)
#define KWRITE() { _Pragma("unroll") for (int rr = 0; rr < 16; ++rr) { const int row_ = rr * 8 + (lane >> 3), piece_ = lane & 7; \
      *(bf16x8*)(Ks + row_ * 128 + ((piece_ ^ (row_ & 7)) * 16)) = vreg[rr]; } }
#define QKSTAGE(SH) { _Pragma("unroll") for (int kbl = 0; kbl < 8; ++kbl) { const int row_ = kbl * 16 + n16; \
      const bf16x8 k0_ = *(const bf16x8*)(Ks + row_ * 128 + ((fq ^ (row_ & 7)) * 16)); \
      const bf16x8 k1_ = *(const bf16x8*)(Ks + row_ * 128 + (((4 + fq) ^ (row_ & 7)) * 16)); \
      f32x4 a_ = {0.f, 0.f, 0.f, 0.f}; a_ = MFMA16(k0_, qf[0], a_); a_ = MFMA16(k1_, qf[1], a_); lg[(SH) * 8 + kbl] = a_; } }
    bf16x8 vreg2[16];
#define LOADKV2(BASECOL, SH) { _Pragma("unroll") for (int rr = 0; rr < 16; ++rr) { \
      const unsigned vo_ = (unsigned)mySel[(SH) * 128 + rr * 8 + (lane >> 3)] * 4608u + (unsigned)(hkv * 128 + (lane & 7) * 16); \
      vreg2[rr] = *(const bf16x8*)((const char*)(Pb + (BASECOL)) + (size_t)vo_); } }
#define KWRITE2() { _Pragma("unroll") for (int rr = 0; rr < 16; ++rr) { const int row_ = rr * 8 + (lane >> 3), piece_ = lane & 7; \
      *(bf16x8*)(Ks + row_ * 128 + ((piece_ ^ (row_ & 7)) * 16)) = vreg2[rr]; } }
    LOADKV(1024, 0)
    LOADKV2(1024, 1)
    asm volatile("s_waitcnt lgkmcnt(0)" ::: "memory");
    KWRITE()
    asm volatile("s_waitcnt lgkmcnt(0)" ::: "memory");
    QKSTAGE(0)
    asm volatile("s_waitcnt lgkmcnt(0)" ::: "memory");
    KWRITE2()
    LOADV(0)
    asm volatile("s_waitcnt lgkmcnt(0)" ::: "memory");
    QKSTAGE(1)
    asm volatile("s_waitcnt lgkmcnt(0)" ::: "memory");
    LOADKV2(1280, 1)
#undef LOADKV2
#undef KWRITE2
#undef KWRITE
#undef QKSTAGE
    float mx = -INFINITY;
#pragma unroll
    for (int kb = 0; kb < 16; ++kb)
#pragma unroll
      for (int i = 0; i < 4; ++i) {
        const int slot = kb * 16 + fq * 4 + i;
        const unsigned bk4 = *(const unsigned*)(mySelb + kb * 16 + fq * 4);
        const int bk = (bk4 >> (8 * i)) & 255;
        const float bv = sbias[bk * 16 + hkv * 4 + (n16 & 3)];
        float v = lg[kb][i] + bv;
        v = (slot < cnt) ? v : -INFINITY;
        lg[kb][i] = v; mx = fmaxf(mx, v);
      }
    mx = fmaxf(mx, shx(mx, 16)); mx = fmaxf(mx, shx(mx, 32));
    float sum = 0.f;
#pragma unroll
    for (int kb = 0; kb < 16; ++kb)
#pragma unroll
      for (int i = 0; i < 4; ++i) { float pv = __builtin_amdgcn_exp2f(lg[kb][i] - mx); lg[kb][i] = pv; sum += pv; }
    sum += shx(sum, 16); sum += shx(sum, 32);
    bf16x8 pall[8];
#pragma unroll
    for (int q = 0; q < 8; ++q)
#pragma unroll
      for (int j = 0; j < 4; ++j) { pall[q][j] = (short)f2bf(lg[2 * q][j]); pall[q][4 + j] = (short)f2bf(lg[2 * q + 1][j]); }
    char* Vs = smem + wave * 16384;
    float invs[4];
#pragma unroll
    for (int i = 0; i < 4; ++i) invs[i] = 1.0f / shidx(sum, i);
    f32x4 oacc[4];
#pragma unroll
    for (int cb = 0; cb < 4; ++cb) oacc[cb] = (f32x4){0.f, 0.f, 0.f, 0.f};
#pragma unroll
    for (int sh = 0; sh < 2; ++sh) {
      asm volatile("s_waitcnt lgkmcnt(0)" ::: "memory");
#pragma unroll
      for (int rr = 0; rr < 16; ++rr) {
        const int row = rr * 8 + (lane >> 3), piece = lane & 7;
        *(bf16x8*)(Vs + row * 128 + (((piece >> 1) ^ ((row >> 1) & 3)) * 32) + (piece & 1) * 16) = (sh == 0) ? vreg[rr] : vreg2[rr];
      }
      asm volatile("s_waitcnt lgkmcnt(0)" ::: "memory");
#pragma unroll
      for (int ks = 0; ks < 4; ++ks) {
        const bf16x8 pa = pall[sh * 4 + ks];
        const int rlo = ks * 32 + fq * 4 + (n16 >> 2);
        const int sw = (rlo >> 1) & 3;
#pragma unroll
        for (int cb = 0; cb < 4; ++cb) {
          const int off = ((cb ^ sw) * 32) + (n16 & 3) * 8;
          s16x4 lo = __builtin_amdgcn_ds_read_tr16_b64_v4i16((__attribute__((address_space(3))) s16x4*)(Vs + rlo * 128 + off));
          s16x4 hi = __builtin_amdgcn_ds_read_tr16_b64_v4i16((__attribute__((address_space(3))) s16x4*)(Vs + (16 + rlo) * 128 + off));
          bf16x8 vb = __builtin_shufflevector(lo, hi, 0, 1, 2, 3, 4, 5, 6, 7);
          oacc[cb] = MFMA16(pa, vb, oacc[cb]);
        }
      }
    }
#undef LOADV
#undef LOADKV
    if (fq == 0) {
      u16* yp = Y + qrow * 1024 + hkv * 256;
#pragma unroll
      for (int i = 0; i < 4; ++i)
#pragma unroll
        for (int cb = 0; cb < 4; ++cb) yp[i * 64 + cb * 16 + n16] = f2bf(oacc[cb][i] * invs[i]);
    }
  }
  __syncthreads();
}

DI float f4c(const float4& v, int k) { return k == 0 ? v.x : (k == 1 ? v.y : (k == 2 ? v.z : v.w)); }
template <int I> struct SolveRows {
  static DI void run(float (&U)[64], const u16* rsrc, const float* rsc, const float* sAm, const float4 (&cur)[16], float rhs) {
    float4 nxt[16]; float rhsn = 0.f;
    if constexpr (I + 1 < 64) {
#pragma unroll
      for (int q = 0; q < (I + 1 + 3) / 4; ++q) nxt[q] = *(const float4*)(sAm + (I + 1) * 68 + q * 4);
      rhsn = bf2f(rsrc[(I + 1) * 136]) * rsc[I + 1];
    }
    __builtin_amdgcn_sched_barrier(0);
    float a = rhs;
#pragma unroll
    for (int j = 0; j < I; ++j) a -= f4c(cur[j >> 2], j & 3) * U[j];
    U[I] = a;
    if constexpr (I + 1 < 64) SolveRows<I + 1>::run(U, rsrc, rsc, sAm, nxt, rhsn);
  }
};
DI void phase_prep_c(int wv_, int vb_, int nvb_, char* ws_, const Ctx& p, char* smem, int half) {
  float* sAm = (float*)smem;
  float* sbeta = sAm + 64 * 68;
  float* sgc = sbeta + 64;
  float* sbg = sgc + 64;
  float* scw = sbg + 64;
  u16* sq = (u16*)(scw + 1536);
  u16* sk = sq + 64 * 136;
  u16* sv = sk + 64 * 136;
  const u16* PQ = (const u16*)(ws_ + WS_CQKV);
  const float* side = (const float*)(ws_ + WS_SIDE);
  u16* halo = (u16*)(ws_ + WS_HALO);
  u16* CW = (u16*)(ws_ + WS_CW); u16* CU = (u16*)(ws_ + WS_CU); u16* CQ = (u16*)(ws_ + WS_CQ);
  u16* CKT = (u16*)(ws_ + WS_CKT); u16* CQK = (u16*)(ws_ + WS_CQK);
  float* GL = (float*)(ws_ + WS_GL);
  const int tid = tidx(wv_), lane = tid & 63, wave = tid >> 6, c = lane & 31, h = lane >> 5;
  for (int k_ = 0; k_ < (2048 + nvb_ - 1) / nvb_; ++k_) {
    const int uix = (vb_ + k_ * nvb_ < 2048) ? vb_ + k_ * nvb_ : 2047;
    const int nc = uix & 31, hd = (uix >> 5) & 7, b = uix >> 8;
    const int n = half * 32 + nc;
    {
      const int tid = tidx(wv_);
      for (int i = tid; i < 1536; i += 256) scw[i] = p.c_conv_w[(i / 384) * 3072 + ((i % 384) >> 7) * 1024 + hd * 128 + (i & 127)];
      __syncthreads();
      const int i = tid >> 2, p4 = tid & 3;
#pragma unroll 1
      for (int which = 0; which < 3; ++which) {
        const int colbase = which * 1024 + hd * 128 + p4 * 32;
        bf16x8 xv[4][4];
#pragma unroll
        for (int j = 0; j < 4; ++j) {
          const int ri = i - 3 + j;
          const u16* src = PQ + ((size_t)b * 2048 + nc * 64 + (ri >= 0 || nc > 0 ? ri : 0)) * 3072 + colbase;
          const bool zr = (ri < 0 && nc == 0 && half == 0);
          if (ri < 0 && nc == 0 && half == 1) src = halo + ((size_t)b * 3 + (3 + ri)) * 3072 + colbase;
#pragma unroll
          for (int q = 0; q < 4; ++q) { bf16x8 t_ = *(const bf16x8*)(src + q * 8);
#pragma unroll
            for (int e = 0; e < 8; ++e) t_[e] = zr ? (short)0 : t_[e];
            xv[j][q] = t_; }
        }
        if (half == 0 && nc == 31 && i >= 61) {
#pragma unroll
          for (int q = 0; q < 4; ++q) *(bf16x8*)(halo + ((size_t)b * 3 + (i - 61)) * 3072 + colbase + q * 8) = xv[3][q];
        }
        float acc[32];
#pragma unroll
        for (int e = 0; e < 32; ++e) acc[e] = 0.f;
#pragma unroll
        for (int j = 0; j < 4; ++j) {
          const float* wp = scw + j * 384 + which * 128 + p4 * 32;
#pragma unroll
          for (int q = 0; q < 4; ++q) {
            const float4 wa = *(const float4*)(wp + q * 8), wb = *(const float4*)(wp + q * 8 + 4);
            acc[q * 8 + 0] += wa.x * bfs(xv[j][q][0]); acc[q * 8 + 1] += wa.y * bfs(xv[j][q][1]); acc[q * 8 + 2] += wa.z * bfs(xv[j][q][2]); acc[q * 8 + 3] += wa.w * bfs(xv[j][q][3]);
            acc[q * 8 + 4] += wb.x * bfs(xv[j][q][4]); acc[q * 8 + 5] += wb.y * bfs(xv[j][q][5]); acc[q * 8 + 6] += wb.z * bfs(xv[j][q][6]); acc[q * 8 + 7] += wb.w * bfs(xv[j][q][7]);
          }
        }
        float ss = 0.f;
#pragma unroll
        for (int e = 0; e < 32; ++e) { float a = acc[e]; a = a * __builtin_amdgcn_rcpf(1.0f + __expf(-a)); acc[e] = a; ss += a * a; }
        float scale = 1.f;
        if (which < 2) {
          ss += shx(ss, 1); ss += shx(ss, 2);
          scale = rsqrtf(ss + 1e-6f);
          if (which == 0) scale *= 0.08838834764831845f;
        }
        u16* dst = (which == 0 ? sq : (which == 1 ? sk : sv)) + i * 136 + p4 * 32;
#pragma unroll
        for (int q = 0; q < 4; ++q) {
          bf16x8 o;
#pragma unroll
          for (int e = 0; e < 8; ++e) o[e] = (short)f2bf(acc[q * 8 + e] * scale);
          *(bf16x8*)(dst + q * 8) = o;
        }
      }
    }
    if ((tidx(wv_) >> 6) == 0) {
      const int lane = tidx(wv_) & 63;
      const size_t tok = (size_t)b * SEQ + n * 64 + lane;
      float bb = side[tok * 16 + hd], aa = side[tok * 16 + 8 + hd];
      float beta = 1.0f / (1.0f + __expf(-bb));
      float xx = aa + p.c_dt_bias[hd];
      float sp = fmaxf(xx, 0.f) + log1pf(__expf(-fabsf(xx)));
      float gcv = -__expf(p.c_a_log[hd]) * sp;
#pragma unroll
      for (int off = 1; off < 64; off <<= 1) { float v = shup(gcv, off); if (lane >= off) gcv += v; }
      sbeta[lane] = beta; sgc[lane] = gcv; sbg[lane] = beta * __expf(gcv);
      if (lane == 63) GL[uix] = __expf(gcv);
    }
    __syncthreads();
    {
      const int tid = tidx(wv_); const int wave = tid >> 6, c = tid & 31, h = (tid >> 5) & 1;
      const int bi = wave >> 1, bj = wave & 1;
      f32x16 akk = zero16(), aqk = zero16();
#pragma unroll
      for (int ks = 0; ks < 8; ++ks) {
        bf16x8 ka = *(const bf16x8*)(sk + (bi * 32 + c) * 136 + ks * 16 + h * 8);
        bf16x8 qa = *(const bf16x8*)(sq + (bi * 32 + c) * 136 + ks * 16 + h * 8);
        bf16x8 kb = *(const bf16x8*)(sk + (bj * 32 + c) * 136 + ks * 16 + h * 8);
        akk = MFMA32(ka, kb, akk); aqk = MFMA32(qa, kb, aqk);
      }
      const int jj = bj * 32 + c;
      const float gj = sgc[jj];
      u16* qko = CQK + (size_t)uix * 4096;
#pragma unroll
      for (int i = 0; i < 16; ++i) {
        const int ii = bi * 32 + crow(i, h);
        const float dg = sgc[ii] - gj;
        const float dec = (jj <= ii) ? __expf(dg) : 0.f;
        sAm[ii * 68 + jj] = (jj < ii) ? sbeta[ii] * akk[i] * dec : 0.f;
        qko[ii * 64 + kpos(jj)] = f2bf(aqk[i] * dec);
      }
    }
    __syncthreads();
    {
      const int tid = tidx(wv_); const int wave = tid >> 6, lane = tid & 63;
      const int cw = wave * 64 + lane;
      const bool isu = wave < 2;
      const u16* rsrc = isu ? (sv + cw) : (sk + (cw - 128));
      const float* rsc = isu ? sbeta : sbg;
      float U[64];
      { float4 c0[16]; SolveRows<0>::run(U, rsrc, rsc, sAm, c0, bf2f(rsrc[0]) * rsc[0]); }
      if (isu) {
        u16* dst = CU + ((size_t)uix * 128 + cw) * 64;
#pragma unroll
        for (int g8 = 0; g8 < 8; ++g8) {
          bf16x8 o;
#pragma unroll
          for (int e = 0; e < 8; ++e) {
            const int pos = g8 * 8 + e;
            const int tb = pos >> 5, hh = (pos >> 4) & 1, ii = pos & 15;
            o[e] = (short)f2bf(U[tb * 32 + crow(ii, hh)]);
          }
          *(bf16x8*)(dst + g8 * 8) = o;
        }
      } else {
        u16* dst = CW + (size_t)uix * 8192 + kpos(cw - 128);
#pragma unroll
        for (int i = 0; i < 64; ++i) dst[i * 128] = f2bf(U[i]);
      }
    }
    {
      const int tid = tidx(wv_);
      const int i = tid >> 2, p4 = tid & 3;
      const float eg = __expf(sgc[i]);
      u16* dst = CQ + (size_t)uix * 8192 + i * 128 + p4 * 32;
      const u16* srow = sq + i * 136 + p4 * 32;
#pragma unroll
      for (int g8 = 0; g8 < 4; ++g8) {
        bf16x8 o;
#pragma unroll
        for (int e = 0; e < 8; ++e) {
          const int pos = g8 * 8 + e;
          const int s = pos >> 4, hh = (pos >> 3) & 1, j = pos & 7;
          const int d = 16 * s + 8 * (j >> 2) + 4 * hh + (j & 3);
          o[e] = (short)f2bf(bf2f(srow[d]) * eg);
        }
        *(bf16x8*)(dst + g8 * 8) = o;
      }
      const int d = tid & 127, th = tid >> 7;
      const float gl = sgc[63];
      u16* dk = CKT + ((size_t)uix * 128 + d) * 64 + th * 32;
#pragma unroll
      for (int g8 = 0; g8 < 4; ++g8) {
        bf16x8 o;
#pragma unroll
        for (int e = 0; e < 8; ++e) {
          const int pos = g8 * 8 + e;
          const int s = pos >> 4, hh = (pos >> 3) & 1, j = pos & 7;
          const int tt = th * 32 + 16 * s + 8 * (j >> 2) + 4 * hh + (j & 3);
          o[e] = (short)f2bf(bf2f(sk[tt * 136 + d]) * __expf(gl - sgc[tt]));
        }
        *(bf16x8*)(dk + g8 * 8) = o;
      }
    }
    __syncthreads();
  }
}

DI void phase_scan_c(int wv_, int vb_, int nvb_, char* ws_, const Ctx& p, char* smem, int half) {
  const u16* CW = (const u16*)(ws_ + WS_CW); const u16* CU = (const u16*)(ws_ + WS_CU); const u16* CQ = (const u16*)(ws_ + WS_CQ);
  const u16* CKT = (const u16*)(ws_ + WS_CKT); const u16* CQK = (const u16*)(ws_ + WS_CQK);
  const float* GL = (const float*)(ws_ + WS_GL);
  float* ST = (float*)(ws_ + WS_STATE);
  u16* O = (u16*)(ws_ + WS_H);
  u16* sW = (u16*)smem;
  u16* sQ = sW + 64 * 136;
  u16* sKT = sQ + 64 * 136;
  u16* sQK = sKT + 128 * 72;
  const int tid = tidx(wv_), lane = tid & 63, wave = tid >> 6, c = lane & 31, h = lane >> 5;
  if ((vb_ >> 1) < 64 && (vb_ & 1)) { for (int q_ = 0; q_ < 66; ++q_) __syncthreads(); }
  if ((vb_ >> 1) < 64 && !(vb_ & 1)) {
    const int blk = vb_ >> 1;
    const int b = blk >> 3, hd = blk & 7, dv0 = wave * 32;
    f32x16 S[4];
    float* stp = ST + ((size_t)(blk * 4 + wave) * 64) * 64 + lane;
    if (half == 0) {
#pragma unroll
      for (int mb = 0; mb < 4; ++mb) S[mb] = zero16();
    } else {
#pragma unroll
      for (int mb = 0; mb < 4; ++mb)
#pragma unroll
        for (int i = 0; i < 16; ++i) S[mb][i] = stp[(mb * 16 + i) * 64];
    }
    bf16x8 gw[4], gq[4], gk[4], gqk[2];
#define SLOAD(UIX) { const size_t u_ = (UIX); \
      _Pragma("unroll") for (int i = 0; i < 4; ++i) { gw[i] = *(const bf16x8*)(CW + u_ * 8192 + (size_t)(tid + 256 * i) * 8); gq[i] = *(const bf16x8*)(CQ + u_ * 8192 + (size_t)(tid + 256 * i) * 8); \
        gk[i] = *(const bf16x8*)(CKT + u_ * 8192 + (size_t)(tid + 256 * i) * 8); } \
      _Pragma("unroll") for (int i = 0; i < 2; ++i) gqk[i] = *(const bf16x8*)(CQK + u_ * 4096 + (size_t)(tid + 256 * i) * 8); }
#define SWRITE() { _Pragma("unroll") for (int i = 0; i < 4; ++i) { const int id_ = tid + 256 * i; \
        *(bf16x8*)(sW + (id_ >> 4) * 136 + (id_ & 15) * 8) = gw[i]; *(bf16x8*)(sQ + (id_ >> 4) * 136 + (id_ & 15) * 8) = gq[i]; \
        *(bf16x8*)(sKT + (id_ >> 3) * 72 + (id_ & 7) * 8) = gk[i]; } \
      _Pragma("unroll") for (int i = 0; i < 2; ++i) { const int id_ = tid + 256 * i; *(bf16x8*)(sQK + (id_ >> 3) * 72 + (id_ & 7) * 8) = gqk[i]; } }
    SLOAD((size_t)blk * 32)
    __syncthreads();
    SWRITE()
    __syncthreads();
#pragma unroll 1
    for (int nc = 0; nc < 32; ++nc) {
      const size_t uix = (size_t)blk * 32 + nc;
      const float egl = GL[uix];
      bf16x8 ucur[4];
#pragma unroll
      for (int tb = 0; tb < 2; ++tb) { ucur[2 * tb] = *(const bf16x8*)(CU + (uix * 128 + dv0 + c) * 64 + h * 16 + tb * 32); ucur[2 * tb + 1] = *(const bf16x8*)(CU + (uix * 128 + dv0 + c) * 64 + h * 16 + tb * 32 + 8); }
      const u16* Wp = sW + c * 136 + h * 8;
      const u16* Qp = sQ + c * 136 + h * 8;
      const u16* KTp = sKT + c * 72 + h * 8;
      const u16* QKp = sQK + c * 72 + h * 8;
      f32x16 X[2], Oa[2];
      X[0] = zero16(); X[1] = zero16(); Oa[0] = zero16(); Oa[1] = zero16();
#pragma unroll
      for (int mb = 0; mb < 4; ++mb) {
#pragma unroll
        for (int s = 0; s < 2; ++s) {
          const bf16x8 sb = pack8(S[mb], s);
#pragma unroll
          for (int tb = 0; tb < 2; ++tb) {
            bf16x8 a = *(const bf16x8*)(Wp + tb * 32 * 136 + mb * 32 + s * 16);
            bf16x8 a2 = *(const bf16x8*)(Qp + tb * 32 * 136 + mb * 32 + s * 16);
            X[tb] = MFMA32(a, sb, X[tb]);
            Oa[tb] = MFMA32(a2, sb, Oa[tb]);
          }
        }
      }
      bf16x8 vb[2][2];
#pragma unroll
      for (int tb = 0; tb < 2; ++tb) {
#pragma unroll
        for (int i = 0; i < 8; ++i) { X[tb][i] = bfs(ucur[2 * tb][i]) - X[tb][i]; X[tb][8 + i] = bfs(ucur[2 * tb + 1][i]) - X[tb][8 + i]; }
        vb[tb][0] = pack8(X[tb], 0); vb[tb][1] = pack8(X[tb], 1);
      }
      { const int ncn = nc < 31 ? nc + 1 : 31; SLOAD((size_t)blk * 32 + ncn) }
#pragma unroll
      for (int tb = 0; tb < 2; ++tb)
#pragma unroll
        for (int tb2 = 0; tb2 < 2; ++tb2)
#pragma unroll
          for (int s = 0; s < 2; ++s) {
            bf16x8 a = *(const bf16x8*)(QKp + tb * 32 * 72 + tb2 * 32 + s * 16);
            Oa[tb] = MFMA32(a, vb[tb2][s], Oa[tb]);
          }
#pragma unroll
      for (int mb = 0; mb < 4; ++mb) {
#pragma unroll
        for (int i = 0; i < 16; ++i) S[mb][i] *= egl;
#pragma unroll
        for (int tb = 0; tb < 2; ++tb)
#pragma unroll
          for (int s = 0; s < 2; ++s) {
            bf16x8 a = *(const bf16x8*)(KTp + mb * 32 * 72 + tb * 32 + s * 16);
            S[mb] = MFMA32(a, vb[tb][s], S[mb]);
          }
      }
      u16* op = O + ((size_t)b * SEQ + (size_t)(half * 32 + nc) * 64) * 1024 + hd * 128 + dv0 + c;
#pragma unroll
      for (int tb = 0; tb < 2; ++tb)
#pragma unroll
        for (int i = 0; i < 16; ++i) op[(size_t)(tb * 32 + crow(i, h)) * 1024] = f2bf(Oa[tb][i]);
      __syncthreads();
      SWRITE()
      __syncthreads();
    }
#undef SLOAD
#undef SWRITE
    if (half == 0) {
#pragma unroll
      for (int mb = 0; mb < 4; ++mb)
#pragma unroll
        for (int i = 0; i < 16; ++i) stp[(mb * 16 + i) * 64] = S[mb][i];
    }
  }
}

DI void phase_outnorm_c(int wv_, int vb_, int nvb_, char* ws_, const Ctx& p) {
  u16* O = (u16*)(ws_ + WS_H); const u16* G = (const u16*)(ws_ + WS_CG);
  const int tid = tidx(wv_); const int e = tid & 15;
  float og[8];
#pragma unroll
  for (int j = 0; j < 8; ++j) og[j] = p.c_o_gain[e * 8 + j];
  const size_t stride = (size_t)nvb_ * 256, total = (size_t)NTOK * 8 * 16;
  for (size_t idx0 = (size_t)vb_ * 256 + tid; idx0 < total; idx0 += 4 * stride) {
    bf16x8 ov[4], gv[4]; bool ok[4];
#pragma unroll
    for (int q = 0; q < 4; ++q) { const size_t idx = idx0 + q * stride; ok[q] = idx < total; const size_t rowh = (ok[q] ? idx : idx0) >> 4;
      ov[q] = *(const bf16x8*)(O + rowh * 128 + e * 8); gv[q] = *(const bf16x8*)(G + rowh * 128 + e * 8); }
#pragma unroll
    for (int q = 0; q < 4; ++q) {
      float f[8]; float ss = 0.f;
#pragma unroll
      for (int j = 0; j < 8; ++j) { f[j] = bfs(ov[q][j]); ss += f[j] * f[j]; }
      ss += shx(ss, 1); ss += shx(ss, 2); ss += shx(ss, 4); ss += shx(ss, 8);
      const float rn = rsqrtf(ss * (1.0f / 128.0f) + 1e-6f);
      bf16x8 o;
#pragma unroll
      for (int j = 0; j < 8; ++j) { float gt = bfs(gv[q][j]); float sl = gt * __builtin_amdgcn_rcpf(1.0f + __expf(-gt)); o[j] = (short)f2bf(f[j] * rn * og[j] * sl); }
      if (ok[q]) *(bf16x8*)(O + ((idx0 + q * stride) >> 4) * 128 + e * 8) = o;
    }
  }
}

#define XB_TMO      128
#define XB_XCNT(j)  (256  + 64 * (j))
#define XB_XSUB(j)  (1280 + 64 * (j))
#define XB_XGEN(j)  (2304 + 64 * (j))
#define XB_TOP      3328
#define XB_TOPGEN   3392
#define XCD_BAR_WORDS 3456
#define XB_SPIN_CAP (1u << 23)
DI unsigned xb_ld(unsigned* p)              { return __hip_atomic_load(p, __ATOMIC_RELAXED, __HIP_MEMORY_SCOPE_AGENT); }
DI unsigned xb_add(unsigned* p, unsigned v) { return __hip_atomic_fetch_add(p, v, __ATOMIC_RELAXED, __HIP_MEMORY_SCOPE_AGENT); }
DI unsigned xb_xcc_id() { return (unsigned)__builtin_amdgcn_s_getreg((3 << 11) | 20) & 0xFu; }
#define XB_SPIN(cond, bar) do { unsigned _sp = 0; while (cond) { __builtin_amdgcn_s_sleep(1); \
    if ((++_sp & 255u) == 0u) { if (xb_ld(&(bar)[XB_TMO])) break; if (_sp > XB_SPIN_CAP) { atomicAdd(&(bar)[XB_TMO], 1u); break; } } } } while (0)
struct XcdBarrier { unsigned* bar; unsigned x; volatile PG8_LAS unsigned* st; };
DI void xcd_barrier_complete(unsigned* bar, unsigned x, unsigned& nloc, unsigned& nx) {
    const unsigned G = gridDim.x;
    unsigned sum, cnt, mine, sp = 0u;
    for (;;) {
        sum = 0u; cnt = 0u; mine = 0u;
#pragma unroll
        for (unsigned j = 0; j < 16; ++j) { const unsigned c = xb_ld(&bar[XB_XCNT(j)]); sum += c; cnt += (c > 0u) ? 1u : 0u; mine = (j == x) ? c : mine; }
        if (sum == G) break;
        __builtin_amdgcn_s_sleep(1);
        if ((++sp & 255u) == 0u) { if (xb_ld(&bar[XB_TMO])) break; if (sp > XB_SPIN_CAP) { atomicAdd(&bar[XB_TMO], 1u); break; } }
    }
    nloc = mine > 0u ? mine : 1u; nx = cnt > 0u ? cnt : 1u;
}
DI void xcd_barrier(char* ws_base, char* lds_base, bool leader_thread) {
    asm volatile("s_waitcnt vmcnt(0)" ::: "memory");
    __syncthreads();
    if (leader_thread) {
        XcdBarrier b; b.bar = (unsigned*)(ws_base + WS_BAR); b.x = xb_xcc_id(); b.st = (volatile PG8_LAS unsigned*)(lds_base + 2 * HALF_LDS);
        unsigned* bar = b.bar;
        __builtin_amdgcn_s_waitcnt(0);
        unsigned nloc = b.st[0], nx = b.st[1];
        if (nloc == 0u) { xcd_barrier_complete(bar, b.x, nloc, nx); b.st[0] = nloc; b.st[1] = nx; }
        const unsigned old = xb_add(&bar[XB_XSUB(b.x)], 1u);
        const unsigned gen = old / nloc;
        if (old + 1u == (gen + 1u) * nloc) {
            __builtin_amdgcn_fence(__ATOMIC_RELEASE, "agent");
            asm volatile("s_waitcnt vmcnt(0)" ::: "memory");
            const unsigned og = xb_add(&bar[XB_TOP], 1u);
            const unsigned tg = og / nx;
            if (og + 1u == (tg + 1u) * nx) xb_add(&bar[XB_TOPGEN], 1u);
            else XB_SPIN(xb_ld(&bar[XB_TOPGEN]) == tg, bar);
            __builtin_amdgcn_fence(__ATOMIC_ACQUIRE, "agent");
            xb_add(&bar[XB_XGEN(b.x)], 1u);
            asm volatile("s_waitcnt vmcnt(0)" ::: "memory");
        } else {
            XB_SPIN(xb_ld(&bar[XB_XGEN(b.x)]) == gen, bar);
            __builtin_amdgcn_fence(__ATOMIC_ACQUIRE, "agent");
            asm volatile("s_waitcnt vmcnt(0)" ::: "memory");
        }
    }
    __syncthreads();
}

template <class Epi>
DI void run_gemm(int wv8_, const u16* A, const u16* Bt, int N, int K, int half, const Epi& E, int G_ = -1, int c_ = -1) {
  extern __shared__ __attribute__((aligned(16))) char smem0[];
  pg8::Gemm g; g.A = A; g.Bt = Bt; g.M = (half < 0) ? NTOK : NTOK / 2; g.N = N; g.K = K; g.half = half;
  pg8::StaticOrder S; S.init(g.M, g.N, G_ > 0 ? G_ : (int)gridDim.x, G_ > 0 ? c_ : (int)blockIdx.x);
  pg8::gemm_phase<Epi, pg8::StaticOrder>((PG8_LAS unsigned char*)smem0, g, S, E, tidx(wv8_));
  __syncthreads();
}

__global__ void __launch_bounds__(512, 2) mega(Params pp) {
  extern __shared__ __attribute__((aligned(16))) char smem0[];
  cg::grid_group grid = cg::this_grid();
  const int wv8_ = __builtin_amdgcn_readfirstlane((int)threadIdx.x >> 6);
  const int hb_ = wv8_ >> 2, wv_ = wv8_ & 3;
  const int vb_ = (int)blockIdx.x * 2 + hb_, nvb_ = (int)gridDim.x * 2;
  {
    volatile PG8_LAS unsigned* st = (volatile PG8_LAS unsigned*)(smem0 + 2 * HALF_LDS);
    const bool lead0 = tidx(wv8_) == 0;
    if (lead0) { st[0] = 0u; st[1] = 0u; (void)xb_add(&((unsigned*)(pp.c.ws + WS_BAR))[XB_XCNT(xb_xcc_id())], 1u); }
    __syncthreads();
  }
  if (pp.ph1 < 0) grid.sync();
#pragma unroll 1
  for (int ph = pp.ph0; ph < pp.ph1; ++ph) {
    const Ctx& p = pp.c;
    size_t wsoff_ = 0; asm volatile("" : "+s"(wsoff_));
    char* ws_ = pp.c.ws + wsoff_;
    unsigned smoff_ = 0; asm volatile("" : "+v"(smoff_));
    char* smem = smem0 + hb_ * HALF_LDS + smoff_;
    const u16* WT = (const u16*)(ws_ + WS_WT);
    u16* H = (u16*)(ws_ + WS_H);
    u16* Pm = (u16*)(ws_ + WS_P);
    const int code = pp.ops[ph];
    const int op = code & 15, l = (code >> 4) & 3, half = (code >> 6) & 1;
    const int kind = l % 3, j = l / 3;
    const float* xcur = (code >> 7) ? p.x : p.out;
    switch (op) {
      case OP_CONVERT: phase_convert(wv_, vb_, nvb_, ws_, p, smem); break;
      case OP_NORM_MIX: phase_norm(wv_, vb_, nvb_, xcur, p.norm_mix + l * DM, H); break;
      case OP_GEMM_IN:
        if (kind == 0) { pg8::EpiB16HN E; E.O = Pm; E.ldc = 4608; E.ncols_norm = 3072; E.nq_cols = 1536; E.gq = p.a_q_gain + j * 64; E.gk = p.a_k_gain + j * 64; E.T = (PG8_LAS float*)(smem0 + 131072);
          run_gemm(wv8_, H, WT + (size_t)j * 4718592u, 4608, 1024, -1, E); }
        else if (kind == 1) { pg8::EpiB16HN E; E.O = Pm; E.ldc = 2304; E.ncols_norm = 1280; E.nq_cols = 1024; E.gq = p.b_q_gain; E.gk = p.b_k_gain; E.T = (PG8_LAS float*)(smem0 + 131072);
          run_gemm(wv8_, H, WT + wOff(4), 2304, 1024, -1, E); }
        else { pg8::EpiCIn E; E.Q = (u16*)(ws_ + WS_CQKV); E.G = (u16*)(ws_ + WS_CG); E.S = (float*)(ws_ + WS_SIDE); E.half = half;
          run_gemm(wv8_, H, WT + wOff(6), 4352, 1024, half, E); }
        break;
      case OP_HEADNORM:
        if (kind == 0) phase_headnorm(wv_, vb_, nvb_, Pm, 4608, 48, 24, p.a_q_gain + j * 64, p.a_k_gain + j * 64);
        else phase_headnorm(wv_, vb_, nvb_, Pm, 2304, 20, 16, p.b_q_gain, p.b_k_gain);
        break;
      case OP_ATTN_A: phase_attn_a(wv_, vb_, nvb_, ws_, p, smem); break;
      case OP_COMBINE_A: phase_combine_a(wv_, vb_, nvb_, ws_, p); break;
      case OP_GEMM_OUT:
      case OP_GEMM_W2: {
        pg8::EpiResid E; E.C = p.out; E.X = xcur;
        const u16* Ag = H; int Kg = 1024; unsigned wo = wOff(7);
        if (op == OP_GEMM_W2) { Ag = Pm; Kg = 4096; wo = wOff(12) + (unsigned)l * 4194304u; }
        else if (kind == 0) { Kg = 512; wo = wOff(2) + (unsigned)j * 524288u; }
        else if (kind == 1) { wo = wOff(5); }
        run_gemm(wv8_, Ag, WT + wo, 1024, Kg, -1, E);
        break; }
      case OP_MIX_B: if (half == 0) phase_mix_b(wv_, vb_, nvb_, ws_, p, smem); else phase_mix_b2(wv_, vb_, nvb_, ws_, p, smem); break;
      case OP_PREP_C: phase_prep_c(wv_, vb_, nvb_, ws_, p, smem, half); break;
      case OP_SCAN_C: phase_scan_c(wv_, vb_, nvb_, ws_, p, smem, half); break;
      case OP_SCAN_GEMM:
        if ((int)blockIdx.x < 64) phase_scan_c(wv_, vb_, nvb_, ws_, p, smem, 0);
        else { pg8::EpiCIn E; E.Q = (u16*)(ws_ + WS_CQKV); E.G = (u16*)(ws_ + WS_CG); E.S = (float*)(ws_ + WS_SIDE); E.half = 1;
          run_gemm(wv8_, H, WT + wOff(6), 4352, 1024, 1, E, (int)gridDim.x - 64, (int)blockIdx.x - 64); }
        break;
      case OP_OUTNORM_C: phase_outnorm_c(wv_, vb_, nvb_, ws_, p); break;
      case OP_NORM_MLP: phase_norm(wv_, vb_, nvb_, xcur, p.norm_mlp + l * DM, H); break;
      case OP_GEMM_W1: { pg8::EpiB16<1> E; E.O = Pm; E.ldc = 4096; run_gemm(wv8_, H, WT + wOff(8) + (size_t)l * 4194304u, 4096, 1024, -1, E); break; }
      default: break;
    }
    const bool noseam = (op == OP_CONVERT) && half;
    if (ph + 1 < pp.ph1 && !noseam) xcd_barrier(ws_, smem0, tidx(wv8_) == 0);
  }
}

#ifndef MIXMASK
#define MIXMASK 15
#endif
#ifndef MULTI_LAUNCH
#define MULTI_LAUNCH 0
#endif
#ifndef REP_W1
#define REP_W1 1
#endif
#ifndef REP_MIXB
#define REP_MIXB 1
#endif
#ifndef REP_MIXB2
#define REP_MIXB2 1
#endif
#ifndef REP_C
#define REP_C 1
#endif
#ifndef REP_SCAN
#define REP_SCAN 1
#endif
#ifndef REP_ATTN
#define REP_ATTN 1
#endif
#ifndef REP_NORM
#define REP_NORM 1
#endif

extern "C" void kernel_launch(void* const* d_in, const int* in_sizes, int n_in, void* d_out, int out_size, void* d_ws, size_t ws_size, hipStream_t stream) {
  static int grid_blocks = 0;
  if (grid_blocks == 0) {
    if (n_in != 20 || ws_size < WS_END) { fprintf(stderr, "kernel_launch: bad n_in %d or ws %zu\n", n_in, ws_size); grid_blocks = -1; return; }
    int dev = 0, cus = 0, per_cu = 0;
    hipGetDevice(&dev);
    hipDeviceGetAttribute(&cus, hipDeviceAttributeMultiprocessorCount, dev);
    if (hipFuncSetAttribute((const void*)mega, hipFuncAttributeMaxDynamicSharedMemorySize, LDS_BYTES) != hipSuccess) { grid_blocks = -1; return; }
    if (hipOccupancyMaxActiveBlocksPerMultiprocessor(&per_cu, (const void*)mega, 512, LDS_BYTES) != hipSuccess || per_cu < 1) per_cu = 1;
    per_cu = 1;
    grid_blocks = cus * per_cu;
    grid_blocks &= ~7;
    fprintf(stderr, "kernel_launch: cus %d per_cu %d grid %d\n", cus, per_cu, grid_blocks);
  }
  if (grid_blocks < 0) return;
  Params p{};
  Ctx& c = p.c;
  c.x = (const float*)d_in[0]; c.rel_bias = (const float*)d_in[1]; c.norm_mix = (const float*)d_in[2]; c.norm_mlp = (const float*)d_in[3];
  c.a_q_gain = (const float*)d_in[7]; c.a_k_gain = (const float*)d_in[8];
  c.b_q_gain = (const float*)d_in[11]; c.b_k_gain = (const float*)d_in[12];
  c.c_conv_w = (const float*)d_in[15]; c.c_a_log = (const float*)d_in[16]; c.c_dt_bias = (const float*)d_in[17]; c.c_o_gain = (const float*)d_in[18];
  c.wbase[0] = (const float*)d_in[6]; c.wbase[1] = (const float*)d_in[9]; c.wbase[2] = (const float*)d_in[10]; c.wbase[3] = (const float*)d_in[13];
  c.wbase[4] = (const float*)d_in[14]; c.wbase[5] = (const float*)d_in[19]; c.wbase[6] = (const float*)d_in[4]; c.wbase[7] = (const float*)d_in[5];
  c.out = (float*)d_out; c.ws = (char*)d_ws;
  int np = 0;
  bool x_in_out = false;
  auto add = [&](int op, int l, int half) {
    int rep = 1;
    if (op == OP_GEMM_W1) rep = REP_W1;
    if (op == OP_MIX_B) rep = half ? REP_MIXB2 : REP_MIXB;
    if (op == OP_PREP_C) rep = REP_C;
    if (op == OP_SCAN_C) rep = REP_SCAN;
    if (op == OP_ATTN_A) rep = REP_ATTN;
    if (op == OP_NORM_MLP || op == OP_NORM_MIX) rep = REP_NORM;
    for (int r = 0; r < rep; ++r) p.ops[np++] = (unsigned char)(op | (l << 4) | (half << 6) | (x_in_out ? 0 : 128));
    if (op == OP_GEMM_OUT || op == OP_GEMM_W2) x_in_out = true;
  };
  add(OP_CONVERT, 0, (MIXMASK & 1) ? 1 : 0);
#ifdef REP_SYNC
  for (int q = 0; q < REP_SYNC; ++q) p.ops[np++] = 15;
#endif
  for (int l = 0; l < 4; ++l) {
    const int kind = l % 3;
    if ((MIXMASK >> l) & 1) {
      add(OP_NORM_MIX, l, 0);
      if (kind == 0) { add(OP_GEMM_IN, l, 0); add(OP_ATTN_A, l, 0); add(OP_COMBINE_A, l, 0); add(OP_GEMM_OUT, l, 0); }
      else if (kind == 1) { add(OP_GEMM_IN, l, 0); add(OP_MIX_B, l, 0); add(OP_MIX_B, l, 1); add(OP_GEMM_OUT, l, 0); }
      else { add(OP_GEMM_IN, l, 0); add(OP_PREP_C, l, 0); add(OP_SCAN_GEMM, l, 0); add(OP_PREP_C, l, 1); add(OP_SCAN_C, l, 1); add(OP_OUTNORM_C, l, 0); add(OP_GEMM_OUT, l, 0); }
    }
    add(OP_NORM_MLP, l, 0); add(OP_GEMM_W1, l, 0); add(OP_GEMM_W2, l, 0);
  }
#if MULTI_LAUNCH
  for (int i = 0; i < np; ++i) {
    p.ph0 = i; p.ph1 = i + 1;
    hipLaunchKernelGGL(mega, dim3(grid_blocks), dim3(512), LDS_BYTES, stream, p);
  }
#else
  p.ph0 = 0; p.ph1 = np;
  (void)hipMemsetAsync((char*)d_ws + WS_BAR, 0, XCD_BAR_WORDS * 4, stream);
  void* args[] = {&p};
  hipError_t e = hipLaunchCooperativeKernel((const void*)mega, dim3(grid_blocks), dim3(512), args, LDS_BYTES, stream);
  if (e != hipSuccess) fprintf(stderr, "cooperative launch failed: %s (grid %d)\n", hipGetErrorString(e), grid_blocks);
#endif
}
```

```cpp
#include <hip/hip_runtime.h>
#include <hip/hip_cooperative_groups.h>
#include <stdint.h>
#include <cstdio>
namespace cg = cooperative_groups;

typedef unsigned short u16;
typedef __attribute__((ext_vector_type(8))) short bf16x8;
typedef __attribute__((ext_vector_type(4))) short s16x4;
typedef __attribute__((ext_vector_type(16))) float f32x16;
typedef __attribute__((ext_vector_type(4))) float f32x4;
#define DI __device__ __forceinline__
#define MFMA32(a, b, c) __builtin_amdgcn_mfma_f32_32x32x16_bf16((a), (b), (c), 0, 0, 0)
#define MFMA16(a, b, c) __builtin_amdgcn_mfma_f32_16x16x32_bf16((a), (b), (c), 0, 0, 0)

constexpr int NTOK = 32768, DM = 1024, SEQ = 4096;
constexpr size_t MiB = 1ull << 20;
constexpr size_t WS_WT = 0, WS_H = 102 * MiB, WS_P = 166 * MiB, WS_E = 454 * MiB, WS_LSE = 486 * MiB,
                 WS_SIDE = 489 * MiB, WS_STATE = 491 * MiB, WS_HALO = 495 * MiB, WS_GL = 495 * MiB + 512 * 1024,
                 WS_BAR = 495 * MiB + 768 * 1024, WS_END = 496 * MiB;
constexpr size_t WS_CQKV = WS_P, WS_CW = WS_P + 96 * MiB, WS_CU = WS_CW + 32 * MiB, WS_CQ = WS_CU + 32 * MiB,
                 WS_CKT = WS_CQ + 32 * MiB, WS_CQK = WS_CKT + 32 * MiB, WS_CG = WS_CQK + 16 * MiB;
static_assert(WS_CG + 64 * MiB <= WS_LSE, "layer C carve-out");
constexpr size_t WS_SEL = WS_P + 150 * MiB, WS_SELB = WS_P + 170 * MiB, WS_CNT = WS_P + 180 * MiB;
constexpr int HALF_LDS = 76800;
constexpr int LDS_BYTES = 2 * HALF_LDS + 16;

enum { OP_CONVERT = 0, OP_NORM_MIX, OP_GEMM_IN, OP_ATTN_A, OP_COMBINE_A, OP_GEMM_OUT, OP_MIX_B, OP_PREP_C, OP_SCAN_C,
       OP_OUTNORM_C, OP_NORM_MLP, OP_GEMM_W1, OP_GEMM_W2, OP_HEADNORM, OP_SCAN_GEMM };

struct Ctx {
  const float* x; const float* rel_bias; const float* norm_mix; const float* norm_mlp;
  const float* a_q_gain; const float* a_k_gain; const float* b_q_gain; const float* b_k_gain;
  const float* c_conv_w; const float* c_a_log; const float* c_dt_bias; const float* c_o_gain;
  const float* wbase[8];
  float* out; char* ws;
};
struct Params { Ctx c; int ph0; int ph1; unsigned char ops[64]; };

constexpr int cK[16] = {1024, 1024, 512, 512, 1024, 1024, 1024, 1024, 1024, 1024, 1024, 1024, 4096, 4096, 4096, 4096};
constexpr int cN[16] = {4608, 4608, 1024, 1024, 2120, 1024, 4112, 1024, 4096, 4096, 4096, 4096, 1024, 1024, 1024, 1024};
constexpr int cNpad[16] = {4608, 4608, 1024, 1024, 2304, 1024, 4352, 1024, 4096, 4096, 4096, 4096, 1024, 1024, 1024, 1024};
constexpr int cBase[16] = {0, 0, 1, 1, 2, 3, 4, 5, 6, 6, 6, 6, 7, 7, 7, 7};
constexpr unsigned cSrcOff[16] = {0, 1024u * 4608u, 0, 512u * 1024u, 0, 0, 0, 0, 0, 4194304u, 2u * 4194304u, 3u * 4194304u, 0, 4194304u, 2u * 4194304u, 3u * 4194304u};
constexpr unsigned wOff(int i) { unsigned o = 0; for (int k = 0; k < i; ++k) o += (unsigned)cK[k] * (unsigned)cNpad[k]; return o; }
constexpr int wTileStart(int i) { int o = 0; for (int k = 0; k < i; ++k) o += (cK[k] / 64) * (cNpad[k] / 64); return o; }
static_assert((size_t)wOff(16) * 2 <= 102 * MiB, "WT region");

template <class T> DI T* lau(T* x) { asm volatile("" : "+s"(x)); return x; }
template <class T> DI T* lauv(T* x) { asm volatile("" : "+v"(x)); return x; }
DI int tidx(int wv) {
  int w = wv;
  asm volatile("" : "+s"(w));
  int l = (int)__builtin_amdgcn_mbcnt_hi(~0u, __builtin_amdgcn_mbcnt_lo(~0u, 0u));
  asm volatile("" : "+v"(l));
  return (w << 6) | l;
}
DI int lane_now() { int l = (int)__builtin_amdgcn_mbcnt_hi(~0u, __builtin_amdgcn_mbcnt_lo(~0u, 0u)); asm volatile("" : "+v"(l)); return l; }
DI float shx(float v, int m) { return __int_as_float(__builtin_amdgcn_ds_bpermute((lane_now() ^ m) << 2, __float_as_int(v))); }
DI int shx(int v, int m) { return __builtin_amdgcn_ds_bpermute((lane_now() ^ m) << 2, v); }
DI float shidx(float v, int src) { return __int_as_float(__builtin_amdgcn_ds_bpermute(src << 2, __float_as_int(v))); }
DI int shidx(int v, int src) { return __builtin_amdgcn_ds_bpermute(src << 2, v); }
DI int shdown(int v, int d) { const int l = lane_now(); return __builtin_amdgcn_ds_bpermute((l + d < 64 ? l + d : l) << 2, v); }
DI float shup(float v, int d) { const int l = lane_now(); return __int_as_float(__builtin_amdgcn_ds_bpermute((l - d >= 0 ? l - d : l) << 2, __float_as_int(v))); }
typedef float f32x2_t __attribute__((ext_vector_type(2)));
typedef __bf16 bf16x2_t __attribute__((ext_vector_type(2)));
DI unsigned pk2bf(float lo, float hi) { const f32x2_t v = {lo, hi}; return __builtin_bit_cast(unsigned, __builtin_convertvector(v, bf16x2_t)); }
DI u16 f2bf(float x) { return (u16)(pk2bf(x, 0.f) & 0xffffu); }
DI float bf2f(u16 v) { return __uint_as_float(((unsigned)v) << 16); }
DI float bfs(short v) { return __uint_as_float(((unsigned)(u16)v) << 16); }
DI int crow(int i, int h) { return (i & 3) + 8 * (i >> 2) + 4 * h; }
DI int kpos(int d) { int e = d & 15; return (d & ~15) + ((e >> 2) & 1) * 8 + (e >> 3) * 4 + (e & 3); }
DI bf16x8 pack8(const f32x16& x, int s) {
  typedef unsigned u32x4_t __attribute__((ext_vector_type(4)));
  u32x4_t r;
  r[0] = pk2bf(x[8 * s + 0], x[8 * s + 1]); r[1] = pk2bf(x[8 * s + 2], x[8 * s + 3]);
  r[2] = pk2bf(x[8 * s + 4], x[8 * s + 5]); r[3] = pk2bf(x[8 * s + 6], x[8 * s + 7]);
  return __builtin_bit_cast(bf16x8, r);
}
DI f32x16 zero16() { f32x16 z;
#pragma unroll
  for (int i = 0; i < 16; ++i) z[i] = 0.f; return z; }
DI bf16x8 zero8() { int zz = 0; asm volatile("" : "+v"(zz)); bf16x8 z;
#pragma unroll
  for (int i = 0; i < 8; ++i) z[i] = (short)zz; return z; }
DI int t5_bucket(int dist) {
  if (dist < 16) return dist;
  float lp = logf((float)dist / 16.0f) / 4.852030263919617f * 16.0f;
  int b = 16 + (int)lp;
  return b < 31 ? b : 31;
}

namespace pg8 {
#define PG8_LAS __attribute__((address_space(3)))
typedef unsigned short bf16_t;
typedef short bf16x8 __attribute__((ext_vector_type(8)));
typedef float f32x4 __attribute__((ext_vector_type(4)));
typedef unsigned u32x4 __attribute__((ext_vector_type(4)));
constexpr int BM = 256, BK = 64, HALF = 128, HTB = HALF * BK * 2  , STAGE_BYTES = 8 * HTB, NXCD = 8, WGM = 8;

__host__ __device__ __forceinline__ int lds_byte(int r, int c) { const int st = (r >> 4) * 2 + (c >> 5), rr = r & 15, cc = c & 31, ob = rr * 64 + cc * 2; return st * 1024 + (ob ^ (((ob >> 9) & 1) << 5)); }
__host__ __device__ __forceinline__ void stage_rc(int b, int& R, int& C) { const int st = b / 1024, sb = b % 1024, swz = sb ^ (((sb >> 9) & 1) << 5); R = (st >> 1) * 16 + swz / 64; C = (st & 1) * 32 + (swz % 64) / 2; }
__host__ __device__ __forceinline__ int perm32(int rho) { const int n = rho >> 4, i = rho & 15; return 8 * (i >> 2) + 4 * n + (i & 3); }

struct Unit { int pm, pn; };
struct Gemm { const bf16_t* A; const bf16_t* Bt; int M, N, K; int half; };
__device__ __forceinline__ size_t a_tile_row(const Gemm& g, int pm) { return g.half < 0 ? (size_t)pm * 256 : (size_t)(pm >> 3) * 4096 + (size_t)g.half * 2048 + (size_t)(pm & 7) * 256; }

struct StaticOrder {
    int nM, nN, nwg, G, c;
    __host__ __device__ void init(int M, int N, int G_, int c_) { nM = M / BM; nN = N / BM; nwg = nM * nN; G = G_; c = c_; }
    __host__ __device__ bool next(int i, Unit& u) const {
        const long L = (long)i * G + c; if (L >= nwg) return false;
        int wgid = (int)L; { const int q = nwg / NXCD, r = nwg % NXCD, xcd = wgid % NXCD, off = wgid / NXCD; wgid = (xcd < r ? xcd * (q + 1) : r * (q + 1) + (xcd - r) * q) + off; }
        const int nig = WGM * nN, gid = wgid / nig, fm = gid * WGM, gsz = (nM - fm) < WGM ? (nM - fm) : WGM;
        u.pm = fm + ((wgid % nig) % gsz); u.pn = (wgid % nig) / gsz; return true;
    }
    __device__ __forceinline__ void a_ready(const Unit&) const {}
    __device__ __forceinline__ void done(const Unit&) const {}
};
__device__ __forceinline__ unsigned cvt_pk_bf16(float lo, float hi) { unsigned r; asm volatile("v_cvt_pk_bf16_f32 %0, %1, %2" : "=v"(r) : "v"(lo), "v"(hi)); return r; }
template <class Epi, class Sched>
__device__ __forceinline__ void gemm_phase(PG8_LAS unsigned char* lds, const Gemm g, const Sched& S, const Epi& E, const int tid) {
    const int wid = __builtin_amdgcn_readfirstlane(tid >> 6), lane = tid & 63, wr = wid >> 2, wc = wid & 3, fr = lane & 15, fq = lane >> 4;
    const int K = g.K, nt = K / BK;
    unsigned voffA[2], voffB[2];
#pragma unroll
    for (int i = 0; i < 2; ++i) { int R, C; stage_rc(tid * 16 + i * 8192, R, C); const int Rb = Epi::PERM ? ((R & ~31) + perm32(R & 31)) : R;
        voffA[i] = (unsigned)(R * K + C) * 2u; voffB[i] = (unsigned)(Rb * K + C) * 2u; }
    const size_t kstep = (size_t)(BK * 2);
    const size_t hstep = (size_t)HALF * K * 2;
    const size_t tstep = 2 * hstep;
    const unsigned ldsw = (unsigned)wid * 1024u;
    const int aoff = lds_byte(wr * 64 + fr, fq * 8), boff = lds_byte(wc * 32 + fr, fq * 8);
#define PG8_SA(b, h) (((b) * 2 + (h)) * HTB)
#define PG8_SB(b, h) ((4 + (b) * 2 + (h)) * HTB)
#define PG8_STAGE(bufoff, gbase, voff) do { _Pragma("unroll") for (int _i = 0; _i < 2; ++_i) \
        __builtin_amdgcn_global_load_lds((const unsigned*)((const char*)(gbase) + (voff)[_i]), (PG8_LAS unsigned*)(lds + (bufoff) + ldsw + _i * 8192), 16, 0, 0); } while (0)
#define PG8_LDA(dst, b, h) do { _Pragma("unroll") for (int m = 0; m < 4; ++m) _Pragma("unroll") for (int k = 0; k < 2; ++k) dst[m][k] = *(const PG8_LAS bf16x8*)(lds + PG8_SA(b, h) + aoff + m * 2048 + k * 1024); } while (0)
#define PG8_LDB(dst, b, h) do { _Pragma("unroll") for (int n = 0; n < 2; ++n) _Pragma("unroll") for (int k = 0; k < 2; ++k) dst[n][k] = *(const PG8_LAS bf16x8*)(lds + PG8_SB(b, h) + boff + n * 2048 + k * 1024); } while (0)
#define PG8_MMA(ai, bj, At, Bt) do { __builtin_amdgcn_s_setprio(1); _Pragma("unroll") for (int m = 0; m < 4; ++m) _Pragma("unroll") for (int n = 0; n < 2; ++n) _Pragma("unroll") for (int k = 0; k < 2; ++k) \
        acc[ai][bj][m][n] = __builtin_amdgcn_mfma_f32_16x16x32_bf16(Bt[n][k], At[m][k], acc[ai][bj][m][n], 0, 0, 0); __builtin_amdgcn_s_setprio(0); } while (0)
#define PG8_WAIT_V(n) asm volatile("s_waitcnt vmcnt(" #n ")" ::: "memory")
#define PG8_WAIT_L(n) asm volatile("s_waitcnt lgkmcnt(" #n ")" ::: "memory")
#define PG8_BAR __builtin_amdgcn_s_barrier()
#define PG8_SCHED __builtin_amdgcn_sched_barrier(0)
    Unit cur, nxt; int ui = 0;
    if (!S.next(0, cur)) return;
    f32x4 acc[2][2][4][2];
#pragma unroll
    for (int a = 0; a < 2; ++a)
#pragma unroll
        for (int b = 0; b < 2; ++b)
#pragma unroll
            for (int m = 0; m < 4; ++m)
#pragma unroll
                for (int n = 0; n < 2; ++n) acc[a][b][m][n] = (f32x4){0.f, 0.f, 0.f, 0.f};
    bf16x8 At[4][2], B0[2][2], B1[2][2];
    const char* cA = (const char*)g.A + a_tile_row(g, cur.pm) * (size_t)K * 2; const char* cB = (const char*)g.Bt + (size_t)cur.pn * tstep;
    S.a_ready(cur);
    PG8_STAGE(PG8_SB(0, 0), cB, voffB); PG8_STAGE(PG8_SA(0, 0), cA, voffA); PG8_STAGE(PG8_SB(0, 1), cB + hstep, voffB); PG8_STAGE(PG8_SA(0, 1), cA + hstep, voffA);
    if (wr == 1) PG8_BAR;
    PG8_WAIT_V(4); PG8_BAR;
    PG8_STAGE(PG8_SB(1, 0), cB + kstep, voffB); PG8_STAGE(PG8_SA(1, 0), cA + kstep, voffA); PG8_STAGE(PG8_SB(1, 1), cB + hstep + kstep, voffB);
    PG8_WAIT_V(6); PG8_BAR;
    for (;;) {
        const bool has_next = S.next(ui + 1, nxt);
        const char* nA = has_next ? (const char*)g.A + a_tile_row(g, nxt.pm) * (size_t)K * 2 : cA; const char* nB = has_next ? (const char*)g.Bt + (size_t)nxt.pn * tstep : cB;
        for (int t = 0; t < nt; t += 2) {
            const bool last = (t == nt - 2);
            const char* a1 = cA + (size_t)(t + 1) * kstep;
            const char* a2 = last ? nA : cA + (size_t)(t + 2) * kstep; const char* b2 = last ? nB : cB + (size_t)(t + 2) * kstep;
            const char* a3 = a2 + kstep; const char* b3 = b2 + kstep;
            if (last && has_next) S.a_ready(nxt);
            PG8_LDB(B0, 0, 0); PG8_SCHED; PG8_LDA(At, 0, 0); PG8_STAGE(PG8_SA(1, 1), a1 + hstep, voffA);
            PG8_WAIT_L(8); PG8_BAR; PG8_WAIT_L(0); PG8_MMA(0, 0, At, B0); PG8_BAR; PG8_SCHED;
            PG8_LDB(B1, 0, 1); PG8_STAGE(PG8_SB(0, 0), b2, voffB);
            PG8_BAR; PG8_WAIT_L(0); PG8_MMA(0, 1, At, B1); PG8_BAR;
            PG8_LDA(At, 0, 1); PG8_STAGE(PG8_SA(0, 0), a2, voffA);
            PG8_BAR; PG8_WAIT_L(0); PG8_MMA(1, 0, At, B0); PG8_BAR; PG8_SCHED;
            PG8_STAGE(PG8_SB(0, 1), b2 + hstep, voffB);
            PG8_WAIT_V(6); PG8_BAR; PG8_MMA(1, 1, At, B1); PG8_BAR;
            PG8_LDB(B0, 1, 0); PG8_SCHED; PG8_LDA(At, 1, 0); PG8_STAGE(PG8_SA(0, 1), a2 + hstep, voffA);
            PG8_WAIT_L(8); PG8_BAR; PG8_WAIT_L(0); PG8_MMA(0, 0, At, B0); PG8_BAR; PG8_SCHED;
            PG8_LDB(B1, 1, 1); PG8_STAGE(PG8_SB(1, 0), b3, voffB);
            PG8_BAR; PG8_WAIT_L(0); PG8_MMA(0, 1, At, B1); PG8_BAR;
            PG8_LDA(At, 1, 1); PG8_STAGE(PG8_SA(1, 0), a3, voffA);
            PG8_BAR; PG8_WAIT_L(0); PG8_MMA(1, 0, At, B0); PG8_BAR; PG8_SCHED;
            PG8_STAGE(PG8_SB(1, 1), b3 + hstep, voffB);
            PG8_WAIT_V(6); PG8_BAR; PG8_MMA(1, 1, At, B1); PG8_BAR;
        }
        if constexpr (!Epi::AFTER_DRAIN) { E(acc, cur, wr, wc, fr, fq); S.done(cur); }
        if (!has_next) break;
#pragma unroll
        for (int a = 0; a < 2; ++a)
#pragma unroll
            for (int b = 0; b < 2; ++b)
#pragma unroll
                for (int m = 0; m < 4; ++m)
#pragma unroll
                    for (int n = 0; n < 2; ++n) acc[a][b][m][n] = (f32x4){0.f, 0.f, 0.f, 0.f};
        cur = nxt; cA = nA; cB = nB; ++ui;
    }
    PG8_WAIT_V(0);
    if (wr == 0) PG8_BAR;
    PG8_BAR;
    if constexpr (Epi::AFTER_DRAIN) { E.fused(acc, cur, wr, wc, fr, fq, lds, wid, lane); S.done(cur); }
#undef PG8_SA
#undef PG8_SB
#undef PG8_STAGE
#undef PG8_LDA
#undef PG8_LDB
#undef PG8_MMA
#undef PG8_WAIT_V
#undef PG8_WAIT_L
#undef PG8_BAR
#undef PG8_SCHED
}
}


namespace pg8 {
template <int ACT> struct EpiB16 {
    static constexpr bool PERM = true, AFTER_DRAIN = false;
    bf16_t* O; int ldc;
    __device__ __forceinline__ void operator()(const f32x4 (&acc)[2][2][4][2], const Unit& u, int wr, int wc, int fr, int fq) const {
        const int row0 = u.pm * BM + wr * 64 + fr, col0 = u.pn * BM + wc * 32 + 8 * fq;
#pragma unroll
        for (int ai = 0; ai < 2; ++ai)
#pragma unroll
            for (int m = 0; m < 4; ++m) { bf16_t* rowp = O + (size_t)(row0 + ai * HALF + m * 16) * ldc + col0;
#pragma unroll
                for (int bj = 0; bj < 2; ++bj) { f32x4 v0 = acc[ai][bj][m][0], v1 = acc[ai][bj][m][1];
                    if (ACT == 1) {
#pragma unroll
                        for (int j = 0; j < 4; ++j) { float a = v0[j] > 0.f ? v0[j] : 0.f, b = v1[j] > 0.f ? v1[j] : 0.f; v0[j] = a * a; v1[j] = b * b; } }
                    u32x4 w; w.x = cvt_pk_bf16(v0[0], v0[1]); w.y = cvt_pk_bf16(v0[2], v0[3]); w.z = cvt_pk_bf16(v1[0], v1[1]); w.w = cvt_pk_bf16(v1[2], v1[3]);
                    *(u32x4*)(rowp + bj * HALF) = w; } }
    }
};
struct EpiB16HN {
    static constexpr bool PERM = true, AFTER_DRAIN = false;
    bf16_t* O; int ldc; int ncols_norm, nq_cols; const float* gq; const float* gk; PG8_LAS float* T;
    __device__ __forceinline__ void operator()(const f32x4 (&acc)[2][2][4][2], const Unit& u, int wr, int wc, int fr, int fq) const {
        const int row0 = u.pm * BM + wr * 64 + fr, col0 = u.pn * BM + wc * 32 + 8 * fq;
        const bool hn = u.pn * BM < ncols_norm;
        float part[2][4][2];
        if (hn) {
#pragma unroll
            for (int ai = 0; ai < 2; ++ai)
#pragma unroll
                for (int m = 0; m < 4; ++m)
#pragma unroll
                    for (int bj = 0; bj < 2; ++bj) { const f32x4 a = acc[ai][bj][m][0], b = acc[ai][bj][m][1];
                        float sq = a[0] * a[0] + a[1] * a[1] + a[2] * a[2] + a[3] * a[3] + b[0] * b[0] + b[1] * b[1] + b[2] * b[2] + b[3] * b[3];
                        sq += shx(sq, 16); sq += shx(sq, 32); part[ai][m][bj] = sq; }
            PG8_LAS float* mine = T + ((wr * 4 + wc) * 16) * 16 + fr;
            if (fq == 0) {
#pragma unroll
                for (int ai = 0; ai < 2; ++ai)
#pragma unroll
                    for (int m = 0; m < 4; ++m)
#pragma unroll
                        for (int bj = 0; bj < 2; ++bj) mine[((ai * 4 + m) * 2 + bj) * 16] = part[ai][m][bj];
            }
            asm volatile("s_waitcnt lgkmcnt(0)" ::: "memory");
            __builtin_amdgcn_s_barrier();
            const PG8_LAS float* other = T + ((wr * 4 + (wc ^ 1)) * 16) * 16 + fr;
#pragma unroll
            for (int ai = 0; ai < 2; ++ai)
#pragma unroll
                for (int m = 0; m < 4; ++m)
#pragma unroll
                    for (int bj = 0; bj < 2; ++bj) part[ai][m][bj] += other[((ai * 4 + m) * 2 + bj) * 16];
        }
        const bool isq = u.pn * BM < nq_cols;
        const float* gp = (isq ? gq : gk) + ((wc & 1) * 32 + 8 * fq);
        const float qs = isq ? 0.125f * 1.4426950408889634f : 1.0f;
        float g8[8];
#pragma unroll
        for (int j = 0; j < 8; ++j) g8[j] = hn ? gp[j] * qs : 1.0f;
#pragma unroll
        for (int ai = 0; ai < 2; ++ai)
#pragma unroll
            for (int m = 0; m < 4; ++m) { bf16_t* rowp = O + (size_t)(row0 + ai * HALF + m * 16) * ldc + col0;
#pragma unroll
                for (int bj = 0; bj < 2; ++bj) { f32x4 v0 = acc[ai][bj][m][0], v1 = acc[ai][bj][m][1];
                    const float r = hn ? rsqrtf(part[ai][m][bj] * (1.0f / 64.0f) + 1e-6f) : 1.0f;
#pragma unroll
                    for (int j = 0; j < 4; ++j) { v0[j] *= r * g8[j]; v1[j] *= r * g8[4 + j]; }
                    u32x4 w; w.x = cvt_pk_bf16(v0[0], v0[1]); w.y = cvt_pk_bf16(v0[2], v0[3]); w.z = cvt_pk_bf16(v1[0], v1[1]); w.w = cvt_pk_bf16(v1[2], v1[3]);
                    *(u32x4*)(rowp + bj * HALF) = w; } }
    }
};
struct EpiResid {
    static constexpr bool PERM = false, AFTER_DRAIN = false;
    float* C; const float* X;
    __device__ __forceinline__ void operator()(const f32x4 (&acc)[2][2][4][2], const Unit& u, int wr, int wc, int fr, int fq) const {
        const int row0 = u.pm * BM + wr * 64 + fr, col0 = u.pn * BM + wc * 32 + 4 * fq;
#pragma unroll
        for (int ai = 0; ai < 2; ++ai) {
            f32x4 xv[4][2][2];
#pragma unroll
            for (int m = 0; m < 4; ++m)
#pragma unroll
                for (int bj = 0; bj < 2; ++bj)
#pragma unroll
                    for (int n = 0; n < 2; ++n) xv[m][bj][n] = *(const f32x4*)(X + (size_t)(row0 + ai * HALF + m * 16) * 1024 + col0 + bj * HALF + n * 16);
#pragma unroll
            for (int m = 0; m < 4; ++m)
#pragma unroll
                for (int bj = 0; bj < 2; ++bj)
#pragma unroll
                    for (int n = 0; n < 2; ++n) *(f32x4*)(C + (size_t)(row0 + ai * HALF + m * 16) * 1024 + col0 + bj * HALF + n * 16) = xv[m][bj][n] + acc[ai][bj][m][n];
        }
    }
};
struct EpiCIn {
    static constexpr bool PERM = true, AFTER_DRAIN = false;
    bf16_t* Q; bf16_t* G; float* S; int half;
    __device__ __forceinline__ void operator()(const f32x4 (&acc)[2][2][4][2], const Unit& u, int wr, int wc, int fr, int fq) const {
        const int rl0 = wr * 64 + fr, cl0 = wc * 32 + 8 * fq;
        const size_t crow0 = (size_t)u.pm * 256, arow0 = (size_t)(u.pm >> 3) * 4096 + (size_t)half * 2048 + (size_t)(u.pm & 7) * 256;
#pragma unroll
        for (int ai = 0; ai < 2; ++ai)
#pragma unroll
            for (int m = 0; m < 4; ++m) { const int rl = rl0 + ai * HALF + m * 16;
#pragma unroll
                for (int bj = 0; bj < 2; ++bj) { const f32x4 v0 = acc[ai][bj][m][0], v1 = acc[ai][bj][m][1]; const int cl = cl0 + bj * HALF;
                    if (u.pn < 16) {
                        u32x4 w; w.x = cvt_pk_bf16(v0[0], v0[1]); w.y = cvt_pk_bf16(v0[2], v0[3]); w.z = cvt_pk_bf16(v1[0], v1[1]); w.w = cvt_pk_bf16(v1[2], v1[3]);
                        if (u.pn < 12) *(u32x4*)(Q + (crow0 + rl) * 3072 + u.pn * 256 + cl) = w;
                        else *(u32x4*)(G + (arow0 + rl) * 1024 + (u.pn - 12) * 256 + cl) = w;
                    } else if (cl < 16) { float* sp = S + (arow0 + rl) * 16 + cl; *(f32x4*)sp = v0; *(f32x4*)(sp + 4) = v1; } } }
    }
};
}

struct CvtTile { const float* src; int K, N, k0, n0; unsigned off; };
DI CvtTile cvt_locate(const Ctx& p, int t) {
  int K = cK[0], N = cN[0], base = 0; unsigned off = 0, soff = 0; int bi = 0;
#define WSEL(i) if (t >= wTileStart(i)) { K = cK[i]; N = cN[i]; base = wTileStart(i); off = wOff(i); soff = cSrcOff[i]; bi = cBase[i]; }
  WSEL(1) WSEL(2) WSEL(3) WSEL(4) WSEL(5) WSEL(6) WSEL(7) WSEL(8) WSEL(9) WSEL(10) WSEL(11) WSEL(12) WSEL(13) WSEL(14) WSEL(15)
#undef WSEL
  const float* src = p.wbase[0];
#pragma unroll
  for (int q = 1; q < 8; ++q) if (bi == q) src = p.wbase[q];
  const int lt = t - base, nkt = K / 64;
  CvtTile c; c.src = src + soff; c.K = K; c.N = N; c.k0 = (lt % nkt) * 64; c.n0 = (lt / nkt) * 64; c.off = off;
  return c;
}
DI void phase_convert(int wv_, int vb_, int nvb_, char* ws_, const Ctx& p, char* smem) {
  float* tile = (float*)smem;
  const int tid = tidx(wv_);
  const int ty = tid >> 4, tx = tid & 15;
  constexpr int total = wTileStart(16);
  const int trips_ = (total + nvb_ - 1) / nvb_;
#define CVT_LOAD(C, V) { _Pragma("unroll") for (int i = 0; i < 4; ++i) { const int n_ = (C).n0 + tx * 4; \
    V[i] = (n_ < (C).N) ? *(const float4*)((C).src + (size_t)((C).k0 + ty + 16 * i) * (C).N + n_) : make_float4(0.f, 0.f, 0.f, 0.f); } }
  CvtTile cur = cvt_locate(p, (vb_ < total) ? vb_ : total - 1);
  float4 v[4];
  CVT_LOAD(cur, v)
  for (int k_ = 0; k_ < trips_; ++k_) {
    const int tn = vb_ + (k_ + 1) * nvb_;
    const CvtTile nxt = cvt_locate(p, (tn < total) ? tn : total - 1);
    float4 vn[4];
    CVT_LOAD(nxt, vn)
#pragma unroll
    for (int i = 0; i < 4; ++i) { float* d = tile + (ty + 16 * i) * 65 + tx * 4; d[0] = v[i].x; d[1] = v[i].y; d[2] = v[i].z; d[3] = v[i].w; }
    __syncthreads();
    {
      const int n = tid >> 2, kq = tid & 3;
      bf16x8 o0, o1;
#pragma unroll
      for (int j = 0; j < 8; ++j) { o0[j] = (short)f2bf(tile[(kq * 16 + j) * 65 + n]); o1[j] = (short)f2bf(tile[(kq * 16 + 8 + j) * 65 + n]); }
      u16* dst = (u16*)(ws_ + WS_WT) + (size_t)cur.off + (size_t)(cur.n0 + n) * cur.K + cur.k0 + kq * 16;
      *(bf16x8*)dst = o0; *(bf16x8*)(dst + 8) = o1;
    }
    __syncthreads();
    cur = nxt;
#pragma unroll
    for (int i = 0; i < 4; ++i) v[i] = vn[i];
  }
#undef CVT_LOAD
}

DI void phase_norm(int wv_, int vb_, int nvb_, const float* x, const float* gain, u16* H) {
  const int tid = tidx(wv_); const int lane = tid & 63, wave = tid >> 6;
  float4 g[4];
#pragma unroll
  for (int c = 0; c < 4; ++c) g[c] = ((const float4*)gain)[c * 64 + lane];
  for (int row0 = (vb_ * 4 + wave) * 4; row0 < NTOK; row0 += nvb_ * 16) {
    float4 v[4][4]; float ss[4];
#pragma unroll
    for (int r = 0; r < 4; ++r) {
      const float4* xr = (const float4*)(x + (size_t)(row0 + r) * DM);
#pragma unroll
      for (int c = 0; c < 4; ++c) v[r][c] = xr[c * 64 + lane];
    }
#pragma unroll
    for (int r = 0; r < 4; ++r) { float a = 0.f;
#pragma unroll
      for (int c = 0; c < 4; ++c) a += v[r][c].x * v[r][c].x + v[r][c].y * v[r][c].y + v[r][c].z * v[r][c].z + v[r][c].w * v[r][c].w;
      ss[r] = a; }
#pragma unroll
    for (int o = 1; o < 64; o <<= 1) {
#pragma unroll
      for (int r = 0; r < 4; ++r) ss[r] += shx(ss[r], o);
    }
#pragma unroll
    for (int r = 0; r < 4; ++r) {
      const float rr = rsqrtf(ss[r] * (1.0f / DM) + 1e-6f);
#pragma unroll
      for (int c = 0; c < 4; ++c) {
        s16x4 o; o[0] = (short)f2bf(v[r][c].x * rr * g[c].x); o[1] = (short)f2bf(v[r][c].y * rr * g[c].y); o[2] = (short)f2bf(v[r][c].z * rr * g[c].z); o[3] = (short)f2bf(v[r][c].w * rr * g[c].w);
        *(s16x4*)(H + (size_t)(row0 + r) * DM + (c * 64 + lane) * 4) = o;
      }
    }
  }
}

DI void phase_headnorm(int wv_, int vb_, int nvb_, u16* P, int ld, int nheads, int nq, const float* gq, const float* gk) {
  const int tid = tidx(wv_);
  const int part = tid & 7;
  const size_t total = (size_t)NTOK * nheads * 8;
  for (size_t idx = (size_t)vb_ * 256 + tid; idx < total; idx += (size_t)nvb_ * 256) {
    const size_t rh = idx >> 3; const size_t row = rh / nheads; const int head = (int)(rh - row * nheads);
    u16* pp = P + row * ld + head * 64 + part * 8;
    bf16x8 v = *(const bf16x8*)pp;
    float f[8]; float ss = 0.f;
#pragma unroll
    for (int j = 0; j < 8; ++j) { f[j] = bfs(v[j]); ss += f[j] * f[j]; }
    ss += shx(ss, 1); ss += shx(ss, 2); ss += shx(ss, 4);
    const float rn = rsqrtf(ss * (1.0f / 64.0f) + 1e-6f) * (head < nq ? 0.125f : 1.0f);
    const float* g = (head < nq ? gq : gk) + part * 8;
    bf16x8 o;
#pragma unroll
    for (int j = 0; j < 8; ++j) o[j] = (short)f2bf(f[j] * rn * g[j]);
    *(bf16x8*)pp = o;
  }
}

DI void phase_attn_a(int wv_, int vb_, int nvb_, char* ws_, const Ctx& p, char* smem) {
  u16* Vt = (u16*)smem;
  float* sBias = (float*)(smem + 64 * 260 * 2);
  const u16* P = (const u16*)(ws_ + WS_P);
  const int tid = tidx(wv_), lane = tid & 63, wave = tid >> 6, c = lane & 31, h = lane >> 5;
  for (int k_ = 0; k_ < (6144 + nvb_ - 1) / nvb_; ++k_) {
    const int u = (vb_ + k_ * nvb_ < 6144) ? vb_ + k_ * nvb_ : 6143;
    const int head = u & 7, g = (u >> 3) % 3, rest = u / 24, idx = rest & 31, b = rest >> 5;
    const int dil = (g == 0) ? 1 : ((g == 1) ? 4 : 16);
    const int nbper = 32 / dil, r = idx / nbper, nb = idx % nbper;
    u16* Og = (g == 0) ? (u16*)(ws_ + WS_H) : ((g == 1) ? (u16*)(ws_ + WS_H + 32 * MiB) : (u16*)(ws_ + WS_E));
    float* lse = (float*)(ws_ + WS_LSE) + (size_t)g * NTOK * 8;
    if (tid <= 128) sBias[tid] = p.rel_bias[t5_bucket(tid * dil) * 40 + g * 8 + head] * 1.4426950408889634f;
    {
      const int kk = tid; const int ksub = nb * 128 - 128 + kk;
      bf16x8 v[8];
      if (ksub >= 0) {
        const u16* vp = P + ((size_t)b * SEQ + (size_t)ksub * dil + r) * 4608 + 3072 + g * 512 + head * 64;
#pragma unroll
        for (int i = 0; i < 8; ++i) v[i] = *(const bf16x8*)(vp + i * 8);
      } else {
#pragma unroll
        for (int i = 0; i < 8; ++i) v[i] = zero8();
      }
#pragma unroll
      for (int i = 0; i < 8; ++i)
#pragma unroll
        for (int jj = 0; jj < 8; ++jj) Vt[(i * 8 + jj) * 260 + kk] = (u16)v[i][jj];
    }
    __syncthreads();
    {
      const int qi = 32 * wave + c;
      const int qtok = (nb * 128 + qi) * dil + r;
      const u16* qp = P + ((size_t)b * SEQ + qtok) * 4608 + g * 512 + head * 64;
      bf16x8 qf[4];
#pragma unroll
      for (int ks = 0; ks < 4; ++ks) qf[ks] = *(const bf16x8*)(qp + ks * 16 + h * 8);
      float mx = -INFINITY, sum = 0.f;
      f32x16 oacc[2]; oacc[0] = zero16(); oacc[1] = zero16();
#pragma unroll 1
      for (int kb = 0; kb < 5; ++kb) {
        const int kk = 32 * wave + 32 * kb + c; const int ksub0 = nb * 128 - 128 + kk;
        bf16x8 kf[4];
        if (ksub0 >= 0) {
          const u16* kp = P + ((size_t)b * SEQ + (size_t)ksub0 * dil + r) * 4608 + 1536 + g * 512 + head * 64;
#pragma unroll
          for (int ks = 0; ks < 4; ++ks) kf[ks] = *(const bf16x8*)(kp + ks * 16 + h * 8);
        } else {
#pragma unroll
          for (int ks = 0; ks < 4; ++ks) kf[ks] = zero8();
        }
        f32x16 sa = zero16();
#pragma unroll
        for (int ks = 0; ks < 4; ++ks) sa = MFMA32(kf[ks], qf[ks], sa);
        float bm = -INFINITY;
        const int sbase = c + 128 - 32 * kb - 4 * h;
        const unsigned slim = (unsigned)((nb * 128 + 32 * wave + c) < 128 ? (nb * 128 + 32 * wave + c) : 128);
        if (nb > 0 && kb >= 1 && kb <= 3) {
#pragma unroll
          for (int i = 0; i < 16; ++i) {
            const int step = sbase - ((i & 3) + 8 * (i >> 2));
            const float v = sa[i] + sBias[step];
            sa[i] = v; bm = fmaxf(bm, v);
          }
        } else {
#pragma unroll
          for (int i = 0; i < 16; ++i) {
            const int step = sbase - ((i & 3) + 8 * (i >> 2));
            const bool valid = (unsigned)step <= slim;
            const float bv = sBias[step];
            float v = valid ? sa[i] + bv : -INFINITY;
            sa[i] = v; bm = fmaxf(bm, v);
          }
        }
        bm = fmaxf(bm, shx(bm, 32));
        const float mnew = fmaxf(mx, bm);
        const float mref = (mnew == -INFINITY) ? 0.f : mnew;
        const float scale = __builtin_amdgcn_exp2f(mx - mref);
        float ps = 0.f;
#pragma unroll
        for (int i = 0; i < 16; ++i) { float pv = __builtin_amdgcn_exp2f(sa[i] - mref); sa[i] = pv; ps += pv; }
        sum = sum * scale + ps; mx = mnew;
#pragma unroll
        for (int i = 0; i < 16; ++i) { oacc[0][i] *= scale; oacc[1][i] *= scale; }
#pragma unroll
        for (int s = 0; s < 2; ++s) {
          bf16x8 pb = pack8(sa, s);
          const int keybase = 32 * wave + 32 * kb + 16 * s;
#pragma unroll
          for (int mb = 0; mb < 2; ++mb) {
            const u16* vr = Vt + (mb * 32 + c) * 260 + keybase + 4 * h;
            s16x4 lo = *(const s16x4*)vr, hi = *(const s16x4*)(vr + 8);
            bf16x8 va = __builtin_shufflevector(lo, hi, 0, 1, 2, 3, 4, 5, 6, 7);
            oacc[mb] = MFMA32(va, pb, oacc[mb]);
          }
        }
      }
      sum += shx(sum, 32);
      const float inv = 1.0f / sum;
      u16* op = Og + ((size_t)b * SEQ + qtok) * 512 + head * 64;
#pragma unroll
      for (int mb = 0; mb < 2; ++mb)
#pragma unroll
        for (int ig = 0; ig < 4; ++ig) {
          s16x4 o;
#pragma unroll
          for (int q = 0; q < 4; ++q) o[q] = (short)f2bf(oacc[mb][ig * 4 + q] * inv);
          *(s16x4*)(op + mb * 32 + 8 * ig + 4 * h) = o;
        }
      if (h == 0) lse[((size_t)b * SEQ + qtok) * 8 + head] = (mx + log2f(sum)) * 0.6931471805599453f;
    }
    __syncthreads();
  }
}

DI void phase_combine_a(int wv_, int vb_, int nvb_, char* ws_, const Ctx& p) {
  u16* O0 = (u16*)(ws_ + WS_H); const u16* O1 = (const u16*)(ws_ + WS_H + 32 * MiB); const u16* O2 = (const u16*)(ws_ + WS_E);
  const float* lse = (const float*)(ws_ + WS_LSE);
  const int tid = tidx(wv_);
  const size_t stride = (size_t)nvb_ * 256, total = (size_t)NTOK * 64;
  for (size_t idx0 = (size_t)vb_ * 256 + tid; idx0 < total; idx0 += 4 * stride) {
    bf16x8 a[4], b[4], cc[4]; float l0[4], l1[4], l2[4]; bool ok[4];
#pragma unroll
    for (int q = 0; q < 4; ++q) {
      const size_t idx = idx0 + q * stride; ok[q] = idx < total; const size_t ix = ok[q] ? idx : idx0;
      const size_t tok = ix >> 6; const int head = (ix >> 3) & 7;
      l0[q] = lse[tok * 8 + head]; l1[q] = lse[(size_t)NTOK * 8 + tok * 8 + head]; l2[q] = lse[(size_t)2 * NTOK * 8 + tok * 8 + head];
      a[q] = *(const bf16x8*)(O0 + ix * 8); b[q] = *(const bf16x8*)(O1 + ix * 8); cc[q] = *(const bf16x8*)(O2 + ix * 8);
    }
#pragma unroll
    for (int q = 0; q < 4; ++q) {
      const float m = fmaxf(l0[q], fmaxf(l1[q], l2[q]));
      float e0 = __expf(l0[q] - m), e1 = __expf(l1[q] - m), e2 = __expf(l2[q] - m);
      const float inv = 1.0f / (e0 + e1 + e2); e0 *= inv; e1 *= inv; e2 *= inv;
      bf16x8 o;
#pragma unroll
      for (int j = 0; j < 8; ++j) o[j] = (short)f2bf(e0 * bfs(a[q][j]) + e1 * bfs(b[q][j]) + e2 * bfs(cc[q][j]));
      if (ok[q]) *(bf16x8*)(O0 + (idx0 + q * stride) * 8) = o;
    }
  }
}

DI unsigned hkey(float s) {
  if (s == 0.f) s = 0.f;
  const _Float16 hv = (_Float16)s;
  const unsigned u = (unsigned)__builtin_bit_cast(unsigned short, hv);
  return (u & 0x8000u) ? (~u & 0xffffu) : (u | 0x8000u);
}

DI void phase_mix_b(int wv_, int vb_, int nvb_, char* ws_, const Ctx& p, char* smem) {
  u16* sc = (u16*)smem;
  unsigned* hist = (unsigned*)(smem + 65536);
  u16* sel = (u16*)(smem + 65536 + 4096);
  const u16* P = (const u16*)(ws_ + WS_P);
  for (int k_ = 0; k_ < (4096 + nvb_ - 1) / nvb_; ++k_) {
    const int it = (vb_ + k_ * nvb_ < 4096) ? vb_ + k_ * nvb_ : 4095;
    const int b = it & 7, qt = 511 - (it >> 3), t0 = qt * 8;
    const u16* Pb = P + (size_t)b * SEQ * 2304;
    {
      const int tid1 = tidx(wv_); const int c = tid1 & 31, h = (tid1 >> 5) & 1, wave = tid1 >> 6;
      const int hd = (c & 3) + 4 * ((c >> 3) & 1), qq = ((c >> 2) & 1) + 2 * (c >> 4);
      bf16x8 qa[2][4];
      float wf[2][2][8];
#pragma unroll
      for (int rb = 0; rb < 2; ++rb) {
#pragma unroll
        for (int ks = 0; ks < 4; ++ks) qa[rb][ks] = *(const bf16x8*)(Pb + (size_t)(t0 + rb * 4 + qq) * 2304 + 1536 + hd * 64 + ks * 16 + h * 8);
#pragma unroll
        for (int q2 = 0; q2 < 2; ++q2) {
          const bf16x8 wv = *(const bf16x8*)(Pb + (size_t)(t0 + rb * 4 + h + 2 * q2) * 2304 + 2112);
#pragma unroll
          for (int j = 0; j < 8; ++j) wf[rb][q2][j] = (bfs(wv[j]) * 0.35355339059327373f) * 0.125f;
        }
      }
      const int nkb = (t0 + 7) / 32 + 1;
#pragma unroll 1
      for (int kb0 = 0; kb0 < nkb; kb0 += 16) {
        bf16x8 kf[4][4];
#pragma unroll
        for (int u = 0; u < 4; ++u) {
          const int kb = kb0 + wave + 4 * u; const int kbc = kb < 127 ? kb : 127;
          const u16* kp = Pb + (size_t)(kbc * 32 + c) * 2304 + 2048 + h * 8;
#pragma unroll
          for (int ks = 0; ks < 4; ++ks) kf[u][ks] = *(const bf16x8*)(kp + ks * 16);
        }
#pragma unroll
        for (int u = 0; u < 4; ++u) {
          const int key = (kb0 + wave + 4 * u) * 32 + c;
#pragma unroll
          for (int rb = 0; rb < 2; ++rb) {
            f32x16 acc = zero16();
#pragma unroll
            for (int ks = 0; ks < 4; ++ks) acc = MFMA32(qa[rb][ks], kf[u][ks], acc);
            float s0 = 0.f, s1 = 0.f;
#pragma unroll
            for (int i = 0; i < 8; ++i) {
              const int hh = (i & 3) + 4 * ((i >> 2) & 1);
              const float a0 = acc[i], a1 = acc[8 + i];
              s0 += wf[rb][0][hh] * (a0 > 0.f ? a0 : 0.f); s1 += wf[rb][1][hh] * (a1 > 0.f ? a1 : 0.f);
            }
            const int q0 = rb * 4 + h, q1 = rb * 4 + h + 2;
            if (key <= t0 + q0) sc[q0 * 4096 + key] = (u16)hkey(s0);
            if (key <= t0 + q1) sc[q1 * 4096 + key] = (u16)hkey(s1);
          }
        }
      }
    }
    __syncthreads();
#pragma unroll 1
    for (int qs = 0; qs < 2; ++qs) {
      const int tid2 = tidx(wv_); const int lane = tid2 & 63, wave = tid2 >> 6;
      const int qsel = wave + 4 * qs;
      const int t = t0 + qsel, n = t + 1;
      const u16* myS = sc + qsel * 4096;
      unsigned* myH = hist + wave * 256;
      unsigned prefix = 0; int need = 256;
#pragma unroll 1
      for (int pass = 0; pass < 2; ++pass) {
        const int shift = 8 - 8 * pass;
        *(uint4*)(myH + lane * 4) = make_uint4(0, 0, 0, 0);
        asm volatile("s_waitcnt lgkmcnt(0)" ::: "memory");
        for (int j8 = lane * 8; j8 < n; j8 += 512) {
          const bf16x8 kv = *(const bf16x8*)(myS + j8);
#pragma unroll
          for (int e = 0; e < 8; ++e) {
            const unsigned u = (unsigned)(u16)kv[e];
            const bool ok = (j8 + e < n) && ((pass == 0) ? true : ((u >> 8) == prefix));
            if (ok) atomicAdd(&myH[(u >> shift) & 255], 1u);
          }
        }
        asm volatile("s_waitcnt lgkmcnt(0)" ::: "memory");
        uint4 hv = *(const uint4*)(myH + lane * 4);
        int tot = (int)(hv.x + hv.y + hv.z + hv.w);
        int incl = tot;
#pragma unroll
        for (int off = 1; off < 64; off <<= 1) { int v = shdown(incl, off); if (lane + off < 64) incl += v; }
        int above = incl - tot;
        bool hit = (above < need) && (need <= incl);
        int bin = 0, nn = need;
        if (hit) {
          int a = above;
          if (need <= a + (int)hv.w) { bin = 3; nn = need - a; }
          else { a += hv.w; if (need <= a + (int)hv.z) { bin = 2; nn = need - a; }
            else { a += hv.z; if (need <= a + (int)hv.y) { bin = 1; nn = need - a; } else { a += hv.y; bin = 0; nn = need - a; } } }
          bin += lane * 4;
        }
        unsigned long long mk = __ballot(hit);
        int src = mk ? (__ffsll((long long)mk) - 1) : 0;
        bin = shidx(bin, src); nn = shidx(nn, src);
        prefix = (prefix << 8) | (unsigned)bin; need = nn;
      }
      u16* mySel = sel + wave * 256;
      int cnt = 0;
      if (n <= 256) {
        for (int j = lane; j < 256; j += 64) mySel[j] = (u16)((j < n) ? j : 0);
        cnt = n;
      } else {
        int eqseen = 0;
        const unsigned long long lt = (1ull << lane) - 1ull;
        for (int j0 = 0; j0 < n; j0 += 64) {
          const int j = j0 + lane; const bool v = j < n;
          unsigned u = v ? (unsigned)myS[j] : 0u;
          const bool gt = v && (u > prefix), eq = v && (u == prefix);
          unsigned long long be = __ballot(eq);
          const bool take = gt || (eq && (eqseen + __popcll(be & lt) < need));
          unsigned long long bt = __ballot(take);
          int pos = cnt + __popcll(bt & lt);
          if (take && pos < 256) mySel[pos] = (u16)j;
          cnt += __popcll(bt); eqseen += __popcll(be);
        }
        if (cnt > 256) cnt = 256;
      }
      asm volatile("s_waitcnt lgkmcnt(0)" ::: "memory");
      {
        u16* gsel = (u16*)(ws_ + WS_SEL) + ((size_t)b * SEQ + t) * 256;
        unsigned char* gselb = (unsigned char*)(ws_ + WS_SELB) + ((size_t)b * SEQ + t) * 256;
        for (int j = lane; j < 256; j += 64) {
          const int tk = (int)mySel[j];
          gsel[j] = (u16)tk;
          gselb[j] = (unsigned char)t5_bucket(t - tk > 0 ? t - tk : 0);
        }
        if (lane == 0) ((int*)(ws_ + WS_CNT))[(size_t)b * SEQ + t] = cnt;
      }
      asm volatile("s_waitcnt lgkmcnt(0)" ::: "memory");
    }
    __syncthreads();
  }
}

DI void phase_mix_b2(int wv_, int vb_, int nvb_, char* ws_, const Ctx& p, char* smem) {
  const u16* P = (const u16*)(ws_ + WS_P);
  u16* Y = (u16*)(ws_ + WS_H);
  float* sbias = (float*)(smem + 65536);
  u16* selL = (u16*)(smem + 65536 + 2048);
  unsigned char* selbL = (unsigned char*)(smem + 65536 + 2048 + 2048);
  {
    const int tid = tidx(wv_);
    for (int i = tid; i < 512; i += 256) sbias[i] = p.rel_bias[(i >> 4) * 40 + 24 + (i & 15)] * 1.4426950408889634f;
  }
  __syncthreads();
  for (int ib = vb_; ib < 32768; ib += nvb_) {
    const int tid = tidx(wv_); const int lane = tid & 63, wave = tid >> 6, n16 = tid & 15, fq = (tid >> 4) & 3;
    const int b = ib & 7, r4 = ib >> 3, hkv = r4 >> 10, t = (r4 & 1023) * 4 + wave;
    const u16* Pb = P + (size_t)b * SEQ * 2304;
    u16* mySel = selL + wave * 256;
    unsigned char* mySelb = selbL + wave * 256;
    const size_t qrow = (size_t)b * SEQ + t;
    const int cnt = ((const int*)(ws_ + WS_CNT))[qrow];
    asm volatile("s_waitcnt lgkmcnt(0)" ::: "memory");
    *(uint2*)(mySel + lane * 4) = *(const uint2*)((const u16*)(ws_ + WS_SEL) + qrow * 256 + lane * 4);
    *(unsigned*)(mySelb + lane * 4) = *(const unsigned*)((const unsigned char*)(ws_ + WS_SELB) + qrow * 256 + lane * 4);
    asm volatile("s_waitcnt lgkmcnt(0)" ::: "memory");
    bf16x8 qf[2];
    {
      const u16* qp = Pb + (size_t)t * 2304 + (hkv * 4 + (n16 & 3)) * 64 + fq * 8;
      qf[0] = *(const bf16x8*)qp; qf[1] = *(const bf16x8*)(qp + 32);
      if (n16 >= 4) { qf[0] = zero8(); qf[1] = zero8(); }
    }
    f32x4 lg[16];
    char* Ks = smem + wave * 16384;
    bf16x8 vreg[16];
#define LOADKV(BASECOL, SH) { _Pragma("unroll") for (int rr = 0; rr < 16; ++rr) { \
      const unsigned vo_ = (unsigned)mySel[(SH) * 128 + rr * 8 + (lane >> 3)] * 4608u + (unsigned)(hkv * 128 + (lane & 7) * 16); \
      vreg[rr] = *(const bf16x8*)((const char*)(Pb + (BASECOL)) + (size_t)vo_); } }
#define LOADV(SH) LOADKV(1280, SH)
#define KWRITE() { _Pragma("unroll") for (int rr = 0; rr < 16; ++rr) { const int row_ = rr * 8 + (lane >> 3), piece_ = lane & 7; \
      *(bf16x8*)(Ks + row_ * 128 + ((piece_ ^ (row_ & 7)) * 16)) = vreg[rr]; } }
#define QKSTAGE(SH) { _Pragma("unroll") for (int kbl = 0; kbl < 8; ++kbl) { const int row_ = kbl * 16 + n16; \
      const bf16x8 k0_ = *(const bf16x8*)(Ks + row_ * 128 + ((fq ^ (row_ & 7)) * 16)); \
      const bf16x8 k1_ = *(const bf16x8*)(Ks + row_ * 128 + (((4 + fq) ^ (row_ & 7)) * 16)); \
      f32x4 a_ = {0.f, 0.f, 0.f, 0.f}; a_ = MFMA16(k0_, qf[0], a_); a_ = MFMA16(k1_, qf[1], a_); lg[(SH) * 8 + kbl] = a_; } }
    bf16x8 vreg2[16];
#define LOADKV2(BASECOL, SH) { _Pragma("unroll") for (int rr = 0; rr < 16; ++rr) { \
      const unsigned vo_ = (unsigned)mySel[(SH) * 128 + rr * 8 + (lane >> 3)] * 4608u + (unsigned)(hkv * 128 + (lane & 7) * 16); \
      vreg2[rr] = *(const bf16x8*)((const char*)(Pb + (BASECOL)) + (size_t)vo_); } }
#define KWRITE2() { _Pragma("unroll") for (int rr = 0; rr < 16; ++rr) { const int row_ = rr * 8 + (lane >> 3), piece_ = lane & 7; \
      *(bf16x8*)(Ks + row_ * 128 + ((piece_ ^ (row_ & 7)) * 16)) = vreg2[rr]; } }
    LOADKV(1024, 0)
    LOADKV2(1024, 1)
    asm volatile("s_waitcnt lgkmcnt(0)" ::: "memory");
    KWRITE()
    asm volatile("s_waitcnt lgkmcnt(0)" ::: "memory");
    QKSTAGE(0)
    asm volatile("s_waitcnt lgkmcnt(0)" ::: "memory");
    KWRITE2()
    LOADV(0)
    asm volatile("s_waitcnt lgkmcnt(0)" ::: "memory");
    QKSTAGE(1)
    asm volatile("s_waitcnt lgkmcnt(0)" ::: "memory");
    LOADKV2(1280, 1)
#undef LOADKV2
#undef KWRITE2
#undef KWRITE
#undef QKSTAGE
    float mx = -INFINITY;
#pragma unroll
    for (int kb = 0; kb < 16; ++kb)
#pragma unroll
      for (int i = 0; i < 4; ++i) {
        const int slot = kb * 16 + fq * 4 + i;
        const unsigned bk4 = *(const unsigned*)(mySelb + kb * 16 + fq * 4);
        const int bk = (bk4 >> (8 * i)) & 255;
        const float bv = sbias[bk * 16 + hkv * 4 + (n16 & 3)];
        float v = lg[kb][i] + bv;
        v = (slot < cnt) ? v : -INFINITY;
        lg[kb][i] = v; mx = fmaxf(mx, v);
      }
    mx = fmaxf(mx, shx(mx, 16)); mx = fmaxf(mx, shx(mx, 32));
    float sum = 0.f;
#pragma unroll
    for (int kb = 0; kb < 16; ++kb)
#pragma unroll
      for (int i = 0; i < 4; ++i) { float pv = __builtin_amdgcn_exp2f(lg[kb][i] - mx); lg[kb][i] = pv; sum += pv; }
    sum += shx(sum, 16); sum += shx(sum, 32);
    bf16x8 pall[8];
#pragma unroll
    for (int q = 0; q < 8; ++q)
#pragma unroll
      for (int j = 0; j < 4; ++j) { pall[q][j] = (short)f2bf(lg[2 * q][j]); pall[q][4 + j] = (short)f2bf(lg[2 * q + 1][j]); }
    char* Vs = smem + wave * 16384;
    float invs[4];
#pragma unroll
    for (int i = 0; i < 4; ++i) invs[i] = 1.0f / shidx(sum, i);
    f32x4 oacc[4];
#pragma unroll
    for (int cb = 0; cb < 4; ++cb) oacc[cb] = (f32x4){0.f, 0.f, 0.f, 0.f};
#pragma unroll
    for (int sh = 0; sh < 2; ++sh) {
      asm volatile("s_waitcnt lgkmcnt(0)" ::: "memory");
#pragma unroll
      for (int rr = 0; rr < 16; ++rr) {
        const int row = rr * 8 + (lane >> 3), piece = lane & 7;
        *(bf16x8*)(Vs + row * 128 + (((piece >> 1) ^ ((row >> 1) & 3)) * 32) + (piece & 1) * 16) = (sh == 0) ? vreg[rr] : vreg2[rr];
      }
      asm volatile("s_waitcnt lgkmcnt(0)" ::: "memory");
#pragma unroll
      for (int ks = 0; ks < 4; ++ks) {
        const bf16x8 pa = pall[sh * 4 + ks];
        const int rlo = ks * 32 + fq * 4 + (n16 >> 2);
        const int sw = (rlo >> 1) & 3;
#pragma unroll
        for (int cb = 0; cb < 4; ++cb) {
          const int off = ((cb ^ sw) * 32) + (n16 & 3) * 8;
          s16x4 lo = __builtin_amdgcn_ds_read_tr16_b64_v4i16((__attribute__((address_space(3))) s16x4*)(Vs + rlo * 128 + off));
          s16x4 hi = __builtin_amdgcn_ds_read_tr16_b64_v4i16((__attribute__((address_space(3))) s16x4*)(Vs + (16 + rlo) * 128 + off));
          bf16x8 vb = __builtin_shufflevector(lo, hi, 0, 1, 2, 3, 4, 5, 6, 7);
          oacc[cb] = MFMA16(pa, vb, oacc[cb]);
        }
      }
    }
#undef LOADV
#undef LOADKV
    if (fq == 0) {
      u16* yp = Y + qrow * 1024 + hkv * 256;
#pragma unroll
      for (int i = 0; i < 4; ++i)
#pragma unroll
        for (int cb = 0; cb < 4; ++cb) yp[i * 64 + cb * 16 + n16] = f2bf(oacc[cb][i] * invs[i]);
    }
  }
  __syncthreads();
}

DI float f4c(const float4& v, int k) { return k == 0 ? v.x : (k == 1 ? v.y : (k == 2 ? v.z : v.w)); }
template <int I> struct SolveRows {
  static DI void run(float (&U)[64], const u16* rsrc, const float* rsc, const float* sAm, const float4 (&cur)[16], float rhs) {
    float4 nxt[16]; float rhsn = 0.f;
    if constexpr (I + 1 < 64) {
#pragma unroll
      for (int q = 0; q < (I + 1 + 3) / 4; ++q) nxt[q] = *(const float4*)(sAm + (I + 1) * 68 + q * 4);
      rhsn = bf2f(rsrc[(I + 1) * 136]) * rsc[I + 1];
    }
    __builtin_amdgcn_sched_barrier(0);
    float a = rhs;
#pragma unroll
    for (int j = 0; j < I; ++j) a -= f4c(cur[j >> 2], j & 3) * U[j];
    U[I] = a;
    if constexpr (I + 1 < 64) SolveRows<I + 1>::run(U, rsrc, rsc, sAm, nxt, rhsn);
  }
};
DI void phase_prep_c(int wv_, int vb_, int nvb_, char* ws_, const Ctx& p, char* smem, int half) {
  float* sAm = (float*)smem;
  float* sbeta = sAm + 64 * 68;
  float* sgc = sbeta + 64;
  float* sbg = sgc + 64;
  float* scw = sbg + 64;
  u16* sq = (u16*)(scw + 1536);
  u16* sk = sq + 64 * 136;
  u16* sv = sk + 64 * 136;
  const u16* PQ = (const u16*)(ws_ + WS_CQKV);
  const float* side = (const float*)(ws_ + WS_SIDE);
  u16* halo = (u16*)(ws_ + WS_HALO);
  u16* CW = (u16*)(ws_ + WS_CW); u16* CU = (u16*)(ws_ + WS_CU); u16* CQ = (u16*)(ws_ + WS_CQ);
  u16* CKT = (u16*)(ws_ + WS_CKT); u16* CQK = (u16*)(ws_ + WS_CQK);
  float* GL = (float*)(ws_ + WS_GL);
  const int tid = tidx(wv_), lane = tid & 63, wave = tid >> 6, c = lane & 31, h = lane >> 5;
  for (int k_ = 0; k_ < (2048 + nvb_ - 1) / nvb_; ++k_) {
    const int uix = (vb_ + k_ * nvb_ < 2048) ? vb_ + k_ * nvb_ : 2047;
    const int nc = uix & 31, hd = (uix >> 5) & 7, b = uix >> 8;
    const int n = half * 32 + nc;
    {
      const int tid = tidx(wv_);
      for (int i = tid; i < 1536; i += 256) scw[i] = p.c_conv_w[(i / 384) * 3072 + ((i % 384) >> 7) * 1024 + hd * 128 + (i & 127)];
      __syncthreads();
      const int i = tid >> 2, p4 = tid & 3;
#pragma unroll 1
      for (int which = 0; which < 3; ++which) {
        const int colbase = which * 1024 + hd * 128 + p4 * 32;
        bf16x8 xv[4][4];
#pragma unroll
        for (int j = 0; j < 4; ++j) {
          const int ri = i - 3 + j;
          const u16* src = PQ + ((size_t)b * 2048 + nc * 64 + (ri >= 0 || nc > 0 ? ri : 0)) * 3072 + colbase;
          const bool zr = (ri < 0 && nc == 0 && half == 0);
          if (ri < 0 && nc == 0 && half == 1) src = halo + ((size_t)b * 3 + (3 + ri)) * 3072 + colbase;
#pragma unroll
          for (int q = 0; q < 4; ++q) { bf16x8 t_ = *(const bf16x8*)(src + q * 8);
#pragma unroll
            for (int e = 0; e < 8; ++e) t_[e] = zr ? (short)0 : t_[e];
            xv[j][q] = t_; }
        }
        if (half == 0 && nc == 31 && i >= 61) {
#pragma unroll
          for (int q = 0; q < 4; ++q) *(bf16x8*)(halo + ((size_t)b * 3 + (i - 61)) * 3072 + colbase + q * 8) = xv[3][q];
        }
        float acc[32];
#pragma unroll
        for (int e = 0; e < 32; ++e) acc[e] = 0.f;
#pragma unroll
        for (int j = 0; j < 4; ++j) {
          const float* wp = scw + j * 384 + which * 128 + p4 * 32;
#pragma unroll
          for (int q = 0; q < 4; ++q) {
            const float4 wa = *(const float4*)(wp + q * 8), wb = *(const float4*)(wp + q * 8 + 4);
            acc[q * 8 + 0] += wa.x * bfs(xv[j][q][0]); acc[q * 8 + 1] += wa.y * bfs(xv[j][q][1]); acc[q * 8 + 2] += wa.z * bfs(xv[j][q][2]); acc[q * 8 + 3] += wa.w * bfs(xv[j][q][3]);
            acc[q * 8 + 4] += wb.x * bfs(xv[j][q][4]); acc[q * 8 + 5] += wb.y * bfs(xv[j][q][5]); acc[q * 8 + 6] += wb.z * bfs(xv[j][q][6]); acc[q * 8 + 7] += wb.w * bfs(xv[j][q][7]);
          }
        }
        float ss = 0.f;
#pragma unroll
        for (int e = 0; e < 32; ++e) { float a = acc[e]; a = a * __builtin_amdgcn_rcpf(1.0f + __expf(-a)); acc[e] = a; ss += a * a; }
        float scale = 1.f;
        if (which < 2) {
          ss += shx(ss, 1); ss += shx(ss, 2);
          scale = rsqrtf(ss + 1e-6f);
          if (which == 0) scale *= 0.08838834764831845f;
        }
        u16* dst = (which == 0 ? sq : (which == 1 ? sk : sv)) + i * 136 + p4 * 32;
#pragma unroll
        for (int q = 0; q < 4; ++q) {
          bf16x8 o;
#pragma unroll
          for (int e = 0; e < 8; ++e) o[e] = (short)f2bf(acc[q * 8 + e] * scale);
          *(bf16x8*)(dst + q * 8) = o;
        }
      }
    }
    if ((tidx(wv_) >> 6) == 0) {
      const int lane = tidx(wv_) & 63;
      const size_t tok = (size_t)b * SEQ + n * 64 + lane;
      float bb = side[tok * 16 + hd], aa = side[tok * 16 + 8 + hd];
      float beta = 1.0f / (1.0f + __expf(-bb));
      float xx = aa + p.c_dt_bias[hd];
      float sp = fmaxf(xx, 0.f) + log1pf(__expf(-fabsf(xx)));
      float gcv = -__expf(p.c_a_log[hd]) * sp;
#pragma unroll
      for (int off = 1; off < 64; off <<= 1) { float v = shup(gcv, off); if (lane >= off) gcv += v; }
      sbeta[lane] = beta; sgc[lane] = gcv; sbg[lane] = beta * __expf(gcv);
      if (lane == 63) GL[uix] = __expf(gcv);
    }
    __syncthreads();
    {
      const int tid = tidx(wv_); const int wave = tid >> 6, c = tid & 31, h = (tid >> 5) & 1;
      const int bi = wave >> 1, bj = wave & 1;
      f32x16 akk = zero16(), aqk = zero16();
#pragma unroll
      for (int ks = 0; ks < 8; ++ks) {
        bf16x8 ka = *(const bf16x8*)(sk + (bi * 32 + c) * 136 + ks * 16 + h * 8);
        bf16x8 qa = *(const bf16x8*)(sq + (bi * 32 + c) * 136 + ks * 16 + h * 8);
        bf16x8 kb = *(const bf16x8*)(sk + (bj * 32 + c) * 136 + ks * 16 + h * 8);
        akk = MFMA32(ka, kb, akk); aqk = MFMA32(qa, kb, aqk);
      }
      const int jj = bj * 32 + c;
      const float gj = sgc[jj];
      u16* qko = CQK + (size_t)uix * 4096;
#pragma unroll
      for (int i = 0; i < 16; ++i) {
        const int ii = bi * 32 + crow(i, h);
        const float dg = sgc[ii] - gj;
        const float dec = (jj <= ii) ? __expf(dg) : 0.f;
        sAm[ii * 68 + jj] = (jj < ii) ? sbeta[ii] * akk[i] * dec : 0.f;
        qko[ii * 64 + kpos(jj)] = f2bf(aqk[i] * dec);
      }
    }
    __syncthreads();
    {
      const int tid = tidx(wv_); const int wave = tid >> 6, lane = tid & 63;
      const int cw = wave * 64 + lane;
      const bool isu = wave < 2;
      const u16* rsrc = isu ? (sv + cw) : (sk + (cw - 128));
      const float* rsc = isu ? sbeta : sbg;
      float U[64];
      { float4 c0[16]; SolveRows<0>::run(U, rsrc, rsc, sAm, c0, bf2f(rsrc[0]) * rsc[0]); }
      if (isu) {
        u16* dst = CU + ((size_t)uix * 128 + cw) * 64;
#pragma unroll
        for (int g8 = 0; g8 < 8; ++g8) {
          bf16x8 o;
#pragma unroll
          for (int e = 0; e < 8; ++e) {
            const int pos = g8 * 8 + e;
            const int tb = pos >> 5, hh = (pos >> 4) & 1, ii = pos & 15;
            o[e] = (short)f2bf(U[tb * 32 + crow(ii, hh)]);
          }
          *(bf16x8*)(dst + g8 * 8) = o;
        }
      } else {
        u16* dst = CW + (size_t)uix * 8192 + kpos(cw - 128);
#pragma unroll
        for (int i = 0; i < 64; ++i) dst[i * 128] = f2bf(U[i]);
      }
    }
    {
      const int tid = tidx(wv_);
      const int i = tid >> 2, p4 = tid & 3;
      const float eg = __expf(sgc[i]);
      u16* dst = CQ + (size_t)uix * 8192 + i * 128 + p4 * 32;
      const u16* srow = sq + i * 136 + p4 * 32;
#pragma unroll
      for (int g8 = 0; g8 < 4; ++g8) {
        bf16x8 o;
#pragma unroll
        for (int e = 0; e < 8; ++e) {
          const int pos = g8 * 8 + e;
          const int s = pos >> 4, hh = (pos >> 3) & 1, j = pos & 7;
          const int d = 16 * s + 8 * (j >> 2) + 4 * hh + (j & 3);
          o[e] = (short)f2bf(bf2f(srow[d]) * eg);
        }
        *(bf16x8*)(dst + g8 * 8) = o;
      }
      const int d = tid & 127, th = tid >> 7;
      const float gl = sgc[63];
      u16* dk = CKT + ((size_t)uix * 128 + d) * 64 + th * 32;
#pragma unroll
      for (int g8 = 0; g8 < 4; ++g8) {
        bf16x8 o;
#pragma unroll
        for (int e = 0; e < 8; ++e) {
          const int pos = g8 * 8 + e;
          const int s = pos >> 4, hh = (pos >> 3) & 1, j = pos & 7;
          const int tt = th * 32 + 16 * s + 8 * (j >> 2) + 4 * hh + (j & 3);
          o[e] = (short)f2bf(bf2f(sk[tt * 136 + d]) * __expf(gl - sgc[tt]));
        }
        *(bf16x8*)(dk + g8 * 8) = o;
      }
    }
    __syncthreads();
  }
}

DI void phase_scan_c(int wv_, int vb_, int nvb_, char* ws_, const Ctx& p, char* smem, int half) {
  const u16* CW = (const u16*)(ws_ + WS_CW); const u16* CU = (const u16*)(ws_ + WS_CU); const u16* CQ = (const u16*)(ws_ + WS_CQ);
  const u16* CKT = (const u16*)(ws_ + WS_CKT); const u16* CQK = (const u16*)(ws_ + WS_CQK);
  const float* GL = (const float*)(ws_ + WS_GL);
  float* ST = (float*)(ws_ + WS_STATE);
  u16* O = (u16*)(ws_ + WS_H);
  u16* sW = (u16*)smem;
  u16* sQ = sW + 64 * 136;
  u16* sKT = sQ + 64 * 136;
  u16* sQK = sKT + 128 * 72;
  const int tid = tidx(wv_), lane = tid & 63, wave = tid >> 6, c = lane & 31, h = lane >> 5;
  if ((vb_ >> 1) < 64 && (vb_ & 1)) { for (int q_ = 0; q_ < 66; ++q_) __syncthreads(); }
  if ((vb_ >> 1) < 64 && !(vb_ & 1)) {
    const int blk = vb_ >> 1;
    const int b = blk >> 3, hd = blk & 7, dv0 = wave * 32;
    f32x16 S[4];
    float* stp = ST + ((size_t)(blk * 4 + wave) * 64) * 64 + lane;
    if (half == 0) {
#pragma unroll
      for (int mb = 0; mb < 4; ++mb) S[mb] = zero16();
    } else {
#pragma unroll
      for (int mb = 0; mb < 4; ++mb)
#pragma unroll
        for (int i = 0; i < 16; ++i) S[mb][i] = stp[(mb * 16 + i) * 64];
    }
    bf16x8 gw[4], gq[4], gk[4], gqk[2];
#define SLOAD(UIX) { const size_t u_ = (UIX); \
      _Pragma("unroll") for (int i = 0; i < 4; ++i) { gw[i] = *(const bf16x8*)(CW + u_ * 8192 + (size_t)(tid + 256 * i) * 8); gq[i] = *(const bf16x8*)(CQ + u_ * 8192 + (size_t)(tid + 256 * i) * 8); \
        gk[i] = *(const bf16x8*)(CKT + u_ * 8192 + (size_t)(tid + 256 * i) * 8); } \
      _Pragma("unroll") for (int i = 0; i < 2; ++i) gqk[i] = *(const bf16x8*)(CQK + u_ * 4096 + (size_t)(tid + 256 * i) * 8); }
#define SWRITE() { _Pragma("unroll") for (int i = 0; i < 4; ++i) { const int id_ = tid + 256 * i; \
        *(bf16x8*)(sW + (id_ >> 4) * 136 + (id_ & 15) * 8) = gw[i]; *(bf16x8*)(sQ + (id_ >> 4) * 136 + (id_ & 15) * 8) = gq[i]; \
        *(bf16x8*)(sKT + (id_ >> 3) * 72 + (id_ & 7) * 8) = gk[i]; } \
      _Pragma("unroll") for (int i = 0; i < 2; ++i) { const int id_ = tid + 256 * i; *(bf16x8*)(sQK + (id_ >> 3) * 72 + (id_ & 7) * 8) = gqk[i]; } }
    SLOAD((size_t)blk * 32)
    __syncthreads();
    SWRITE()
    __syncthreads();
#pragma unroll 1
    for (int nc = 0; nc < 32; ++nc) {
      const size_t uix = (size_t)blk * 32 + nc;
      const float egl = GL[uix];
      bf16x8 ucur[4];
#pragma unroll
      for (int tb = 0; tb < 2; ++tb) { ucur[2 * tb] = *(const bf16x8*)(CU + (uix * 128 + dv0 + c) * 64 + h * 16 + tb * 32); ucur[2 * tb + 1] = *(const bf16x8*)(CU + (uix * 128 + dv0 + c) * 64 + h * 16 + tb * 32 + 8); }
      const u16* Wp = sW + c * 136 + h * 8;
      const u16* Qp = sQ + c * 136 + h * 8;
      const u16* KTp = sKT + c * 72 + h * 8;
      const u16* QKp = sQK + c * 72 + h * 8;
      f32x16 X[2], Oa[2];
      X[0] = zero16(); X[1] = zero16(); Oa[0] = zero16(); Oa[1] = zero16();
#pragma unroll
      for (int mb = 0; mb < 4; ++mb) {
#pragma unroll
        for (int s = 0; s < 2; ++s) {
          const bf16x8 sb = pack8(S[mb], s);
#pragma unroll
          for (int tb = 0; tb < 2; ++tb) {
            bf16x8 a = *(const bf16x8*)(Wp + tb * 32 * 136 + mb * 32 + s * 16);
            bf16x8 a2 = *(const bf16x8*)(Qp + tb * 32 * 136 + mb * 32 + s * 16);
            X[tb] = MFMA32(a, sb, X[tb]);
            Oa[tb] = MFMA32(a2, sb, Oa[tb]);
          }
        }
      }
      bf16x8 vb[2][2];
#pragma unroll
      for (int tb = 0; tb < 2; ++tb) {
#pragma unroll
        for (int i = 0; i < 8; ++i) { X[tb][i] = bfs(ucur[2 * tb][i]) - X[tb][i]; X[tb][8 + i] = bfs(ucur[2 * tb + 1][i]) - X[tb][8 + i]; }
        vb[tb][0] = pack8(X[tb], 0); vb[tb][1] = pack8(X[tb], 1);
      }
      { const int ncn = nc < 31 ? nc + 1 : 31; SLOAD((size_t)blk * 32 + ncn) }
#pragma unroll
      for (int tb = 0; tb < 2; ++tb)
#pragma unroll
        for (int tb2 = 0; tb2 < 2; ++tb2)
#pragma unroll
          for (int s = 0; s < 2; ++s) {
            bf16x8 a = *(const bf16x8*)(QKp + tb * 32 * 72 + tb2 * 32 + s * 16);
            Oa[tb] = MFMA32(a, vb[tb2][s], Oa[tb]);
          }
#pragma unroll
      for (int mb = 0; mb < 4; ++mb) {
#pragma unroll
        for (int i = 0; i < 16; ++i) S[mb][i] *= egl;
#pragma unroll
        for (int tb = 0; tb < 2; ++tb)
#pragma unroll
          for (int s = 0; s < 2; ++s) {
            bf16x8 a = *(const bf16x8*)(KTp + mb * 32 * 72 + tb * 32 + s * 16);
            S[mb] = MFMA32(a, vb[tb][s], S[mb]);
          }
      }
      u16* op = O + ((size_t)b * SEQ + (size_t)(half * 32 + nc) * 64) * 1024 + hd * 128 + dv0 + c;
#pragma unroll
      for (int tb = 0; tb < 2; ++tb)
#pragma unroll
        for (int i = 0; i < 16; ++i) op[(size_t)(tb * 32 + crow(i, h)) * 1024] = f2bf(Oa[tb][i]);
      __syncthreads();
      SWRITE()
      __syncthreads();
    }
#undef SLOAD
#undef SWRITE
    if (half == 0) {
#pragma unroll
      for (int mb = 0; mb < 4; ++mb)
#pragma unroll
        for (int i = 0; i < 16; ++i) stp[(mb * 16 + i) * 64] = S[mb][i];
    }
  }
}

DI void phase_outnorm_c(int wv_, int vb_, int nvb_, char* ws_, const Ctx& p) {
  u16* O = (u16*)(ws_ + WS_H); const u16* G = (const u16*)(ws_ + WS_CG);
  const int tid = tidx(wv_); const int e = tid & 15;
  float og[8];
#pragma unroll
  for (int j = 0; j < 8; ++j) og[j] = p.c_o_gain[e * 8 + j];
  const size_t stride = (size_t)nvb_ * 256, total = (size_t)NTOK * 8 * 16;
  for (size_t idx0 = (size_t)vb_ * 256 + tid; idx0 < total; idx0 += 4 * stride) {
    bf16x8 ov[4], gv[4]; bool ok[4];
#pragma unroll
    for (int q = 0; q < 4; ++q) { const size_t idx = idx0 + q * stride; ok[q] = idx < total; const size_t rowh = (ok[q] ? idx : idx0) >> 4;
      ov[q] = *(const bf16x8*)(O + rowh * 128 + e * 8); gv[q] = *(const bf16x8*)(G + rowh * 128 + e * 8); }
#pragma unroll
    for (int q = 0; q < 4; ++q) {
      float f[8]; float ss = 0.f;
#pragma unroll
      for (int j = 0; j < 8; ++j) { f[j] = bfs(ov[q][j]); ss += f[j] * f[j]; }
      ss += shx(ss, 1); ss += shx(ss, 2); ss += shx(ss, 4); ss += shx(ss, 8);
      const float rn = rsqrtf(ss * (1.0f / 128.0f) + 1e-6f);
      bf16x8 o;
#pragma unroll
      for (int j = 0; j < 8; ++j) { float gt = bfs(gv[q][j]); float sl = gt * __builtin_amdgcn_rcpf(1.0f + __expf(-gt)); o[j] = (short)f2bf(f[j] * rn * og[j] * sl); }
      if (ok[q]) *(bf16x8*)(O + ((idx0 + q * stride) >> 4) * 128 + e * 8) = o;
    }
  }
}

#define XB_TMO      128
#define XB_XCNT(j)  (256  + 64 * (j))
#define XB_XSUB(j)  (1280 + 64 * (j))
#define XB_XGEN(j)  (2304 + 64 * (j))
#define XB_TOP      3328
#define XB_TOPGEN   3392
#define XCD_BAR_WORDS 3456
#define XB_SPIN_CAP (1u << 23)
DI unsigned xb_ld(unsigned* p)              { return __hip_atomic_load(p, __ATOMIC_RELAXED, __HIP_MEMORY_SCOPE_AGENT); }
DI unsigned xb_add(unsigned* p, unsigned v) { return __hip_atomic_fetch_add(p, v, __ATOMIC_RELAXED, __HIP_MEMORY_SCOPE_AGENT); }
DI unsigned xb_xcc_id() { return (unsigned)__builtin_amdgcn_s_getreg((3 << 11) | 20) & 0xFu; }
#define XB_SPIN(cond, bar) do { unsigned _sp = 0; while (cond) { __builtin_amdgcn_s_sleep(1); \
    if ((++_sp & 255u) == 0u) { if (xb_ld(&(bar)[XB_TMO])) break; if (_sp > XB_SPIN_CAP) { atomicAdd(&(bar)[XB_TMO], 1u); break; } } } } while (0)
struct XcdBarrier { unsigned* bar; unsigned x; volatile PG8_LAS unsigned* st; };
DI void xcd_barrier_complete(unsigned* bar, unsigned x, unsigned& nloc, unsigned& nx) {
    const unsigned G = gridDim.x;
    unsigned sum, cnt, mine, sp = 0u;
    for (;;) {
        sum = 0u; cnt = 0u; mine = 0u;
#pragma unroll
        for (unsigned j = 0; j < 16; ++j) { const unsigned c = xb_ld(&bar[XB_XCNT(j)]); sum += c; cnt += (c > 0u) ? 1u : 0u; mine = (j == x) ? c : mine; }
        if (sum == G) break;
        __builtin_amdgcn_s_sleep(1);
        if ((++sp & 255u) == 0u) { if (xb_ld(&bar[XB_TMO])) break; if (sp > XB_SPIN_CAP) { atomicAdd(&bar[XB_TMO], 1u); break; } }
    }
    nloc = mine > 0u ? mine : 1u; nx = cnt > 0u ? cnt : 1u;
}
DI void xcd_barrier(char* ws_base, char* lds_base, bool leader_thread) {
    asm volatile("s_waitcnt vmcnt(0)" ::: "memory");
    __syncthreads();
    if (leader_thread) {
        XcdBarrier b; b.bar = (unsigned*)(ws_base + WS_BAR); b.x = xb_xcc_id(); b.st = (volatile PG8_LAS unsigned*)(lds_base + 2 * HALF_LDS);
        unsigned* bar = b.bar;
        __builtin_amdgcn_s_waitcnt(0);
        unsigned nloc = b.st[0], nx = b.st[1];
        if (nloc == 0u) { xcd_barrier_complete(bar, b.x, nloc, nx); b.st[0] = nloc; b.st[1] = nx; }
        const unsigned old = xb_add(&bar[XB_XSUB(b.x)], 1u);
        const unsigned gen = old / nloc;
        if (old + 1u == (gen + 1u) * nloc) {
            __builtin_amdgcn_fence(__ATOMIC_RELEASE, "agent");
            asm volatile("s_waitcnt vmcnt(0)" ::: "memory");
            const unsigned og = xb_add(&bar[XB_TOP], 1u);
            const unsigned tg = og / nx;
            if (og + 1u == (tg + 1u) * nx) xb_add(&bar[XB_TOPGEN], 1u);
            else XB_SPIN(xb_ld(&bar[XB_TOPGEN]) == tg, bar);
            __builtin_amdgcn_fence(__ATOMIC_ACQUIRE, "agent");
            xb_add(&bar[XB_XGEN(b.x)], 1u);
            asm volatile("s_waitcnt vmcnt(0)" ::: "memory");
        } else {
            XB_SPIN(xb_ld(&bar[XB_XGEN(b.x)]) == gen, bar);
            __builtin_amdgcn_fence(__ATOMIC_ACQUIRE, "agent");
            asm volatile("s_waitcnt vmcnt(0)" ::: "memory");
        }
    }
    __syncthreads();
}

template <class Epi>
DI void run_gemm(int wv8_, const u16* A, const u16* Bt, int N, int K, int half, const Epi& E, int G_ = -1, int c_ = -1) {
  extern __shared__ __attribute__((aligned(16))) char smem0[];
  pg8::Gemm g; g.A = A; g.Bt = Bt; g.M = (half < 0) ? NTOK : NTOK / 2; g.N = N; g.K = K; g.half = half;
  pg8::StaticOrder S; S.init(g.M, g.N, G_ > 0 ? G_ : (int)gridDim.x, G_ > 0 ? c_ : (int)blockIdx.x);
  pg8::gemm_phase<Epi, pg8::StaticOrder>((PG8_LAS unsigned char*)smem0, g, S, E, tidx(wv8_));
  __syncthreads();
}

__global__ void __launch_bounds__(512, 2) mega(Params pp) {
  extern __shared__ __attribute__((aligned(16))) char smem0[];
  cg::grid_group grid = cg::this_grid();
  const int wv8_ = __builtin_amdgcn_readfirstlane((int)threadIdx.x >> 6);
  const int hb_ = wv8_ >> 2, wv_ = wv8_ & 3;
  const int vb_ = (int)blockIdx.x * 2 + hb_, nvb_ = (int)gridDim.x * 2;
  {
    volatile PG8_LAS unsigned* st = (volatile PG8_LAS unsigned*)(smem0 + 2 * HALF_LDS);
    const bool lead0 = tidx(wv8_) == 0;
    if (lead0) { st[0] = 0u; st[1] = 0u; (void)xb_add(&((unsigned*)(pp.c.ws + WS_BAR))[XB_XCNT(xb_xcc_id())], 1u); }
    __syncthreads();
  }
  if (pp.ph1 < 0) grid.sync();
#pragma unroll 1
  for (int ph = pp.ph0; ph < pp.ph1; ++ph) {
    const Ctx& p = pp.c;
    size_t wsoff_ = 0; asm volatile("" : "+s"(wsoff_));
    char* ws_ = pp.c.ws + wsoff_;
    unsigned smoff_ = 0; asm volatile("" : "+v"(smoff_));
    char* smem = smem0 + hb_ * HALF_LDS + smoff_;
    const u16* WT = (const u16*)(ws_ + WS_WT);
    u16* H = (u16*)(ws_ + WS_H);
    u16* Pm = (u16*)(ws_ + WS_P);
    const int code = pp.ops[ph];
    const int op = code & 15, l = (code >> 4) & 3, half = (code >> 6) & 1;
    const int kind = l % 3, j = l / 3;
    const float* xcur = (code >> 7) ? p.x : p.out;
    switch (op) {
      case OP_CONVERT: phase_convert(wv_, vb_, nvb_, ws_, p, smem); break;
      case OP_NORM_MIX: phase_norm(wv_, vb_, nvb_, xcur, p.norm_mix + l * DM, H); break;
      case OP_GEMM_IN:
        if (kind == 0) { pg8::EpiB16HN E; E.O = Pm; E.ldc = 4608; E.ncols_norm = 3072; E.nq_cols = 1536; E.gq = p.a_q_gain + j * 64; E.gk = p.a_k_gain + j * 64; E.T = (PG8_LAS float*)(smem0 + 131072);
          run_gemm(wv8_, H, WT + (size_t)j * 4718592u, 4608, 1024, -1, E); }
        else if (kind == 1) { pg8::EpiB16HN E; E.O = Pm; E.ldc = 2304; E.ncols_norm = 1280; E.nq_cols = 1024; E.gq = p.b_q_gain; E.gk = p.b_k_gain; E.T = (PG8_LAS float*)(smem0 + 131072);
          run_gemm(wv8_, H, WT + wOff(4), 2304, 1024, -1, E); }
        else { pg8::EpiCIn E; E.Q = (u16*)(ws_ + WS_CQKV); E.G = (u16*)(ws_ + WS_CG); E.S = (float*)(ws_ + WS_SIDE); E.half = half;
          run_gemm(wv8_, H, WT + wOff(6), 4352, 1024, half, E); }
        break;
      case OP_HEADNORM:
        if (kind == 0) phase_headnorm(wv_, vb_, nvb_, Pm, 4608, 48, 24, p.a_q_gain + j * 64, p.a_k_gain + j * 64);
        else phase_headnorm(wv_, vb_, nvb_, Pm, 2304, 20, 16, p.b_q_gain, p.b_k_gain);
        break;
      case OP_ATTN_A: phase_attn_a(wv_, vb_, nvb_, ws_, p, smem); break;
      case OP_COMBINE_A: phase_combine_a(wv_, vb_, nvb_, ws_, p); break;
      case OP_GEMM_OUT:
      case OP_GEMM_W2: {
        pg8::EpiResid E; E.C = p.out; E.X = xcur;
        const u16* Ag = H; int Kg = 1024; unsigned wo = wOff(7);
        if (op == OP_GEMM_W2) { Ag = Pm; Kg = 4096; wo = wOff(12) + (unsigned)l * 4194304u; }
        else if (kind == 0) { Kg = 512; wo = wOff(2) + (unsigned)j * 524288u; }
        else if (kind == 1) { wo = wOff(5); }
        run_gemm(wv8_, Ag, WT + wo, 1024, Kg, -1, E);
        break; }
      case OP_MIX_B: if (half == 0) phase_mix_b(wv_, vb_, nvb_, ws_, p, smem); else phase_mix_b2(wv_, vb_, nvb_, ws_, p, smem); break;
      case OP_PREP_C: phase_prep_c(wv_, vb_, nvb_, ws_, p, smem, half); break;
      case OP_SCAN_C: phase_scan_c(wv_, vb_, nvb_, ws_, p, smem, half); break;
      case OP_SCAN_GEMM:
        if ((int)blockIdx.x < 64) phase_scan_c(wv_, vb_, nvb_, ws_, p, smem, 0);
        else { pg8::EpiCIn E; E.Q = (u16*)(ws_ + WS_CQKV); E.G = (u16*)(ws_ + WS_CG); E.S = (float*)(ws_ + WS_SIDE); E.half = 1;
          run_gemm(wv8_, H, WT + wOff(6), 4352, 1024, 1, E, (int)gridDim.x - 64, (int)blockIdx.x - 64); }
        break;
      case OP_OUTNORM_C: phase_outnorm_c(wv_, vb_, nvb_, ws_, p); break;
      case OP_NORM_MLP: phase_norm(wv_, vb_, nvb_, xcur, p.norm_mlp + l * DM, H); break;
      case OP_GEMM_W1: { pg8::EpiB16<1> E; E.O = Pm; E.ldc = 4096; run_gemm(wv8_, H, WT + wOff(8) + (size_t)l * 4194304u, 4096, 1024, -1, E); break; }
      default: break;
    }
    const bool noseam = (op == OP_CONVERT) && half;
    if (ph + 1 < pp.ph1 && !noseam) xcd_barrier(ws_, smem0, tidx(wv8_) == 0);
  }
}

#ifndef MIXMASK
#define MIXMASK 15
#endif
#ifndef MULTI_LAUNCH
#define MULTI_LAUNCH 0
#endif
#ifndef REP_W1
#define REP_W1 1
#endif
#ifndef REP_MIXB
#define REP_MIXB 1
#endif
#ifndef REP_MIXB2
#define REP_MIXB2 1
#endif
#ifndef REP_C
#define REP_C 1
#endif
#ifndef REP_SCAN
#define REP_SCAN 1
#endif
#ifndef REP_ATTN
#define REP_ATTN 1
#endif
#ifndef REP_NORM
#define REP_NORM 1
#endif

extern "C" void kernel_launch(void* const* d_in, const int* in_sizes, int n_in, void* d_out, int out_size, void* d_ws, size_t ws_size, hipStream_t stream) {
  static int grid_blocks = 0;
  if (grid_blocks == 0) {
    if (n_in != 20 || ws_size < WS_END) { fprintf(stderr, "kernel_launch: bad n_in %d or ws %zu\n", n_in, ws_size); grid_blocks = -1; return; }
    int dev = 0, cus = 0, per_cu = 0;
    hipGetDevice(&dev);
    hipDeviceGetAttribute(&cus, hipDeviceAttributeMultiprocessorCount, dev);
    if (hipFuncSetAttribute((const void*)mega, hipFuncAttributeMaxDynamicSharedMemorySize, LDS_BYTES) != hipSuccess) { grid_blocks = -1; return; }
    if (hipOccupancyMaxActiveBlocksPerMultiprocessor(&per_cu, (const void*)mega, 512, LDS_BYTES) != hipSuccess || per_cu < 1) per_cu = 1;
    per_cu = 1;
    grid_blocks = cus * per_cu;
    grid_blocks &= ~7;
    fprintf(stderr, "kernel_launch: cus %d per_cu %d grid %d\n", cus, per_cu, grid_blocks);
  }
  if (grid_blocks < 0) return;
  Params p{};
  Ctx& c = p.c;
  c.x = (const float*)d_in[0]; c.rel_bias = (const float*)d_in[1]; c.norm_mix = (const float*)d_in[2]; c.norm_mlp = (const float*)d_in[3];
  c.a_q_gain = (const float*)d_in[7]; c.a_k_gain = (const float*)d_in[8];
  c.b_q_gain = (const float*)d_in[11]; c.b_k_gain = (const float*)d_in[12];
  c.c_conv_w = (const float*)d_in[15]; c.c_a_log = (const float*)d_in[16]; c.c_dt_bias = (const float*)d_in[17]; c.c_o_gain = (const float*)d_in[18];
  c.wbase[0] = (const float*)d_in[6]; c.wbase[1] = (const float*)d_in[9]; c.wbase[2] = (const float*)d_in[10]; c.wbase[3] = (const float*)d_in[13];
  c.wbase[4] = (const float*)d_in[14]; c.wbase[5] = (const float*)d_in[19]; c.wbase[6] = (const float*)d_in[4]; c.wbase[7] = (const float*)d_in[5];
  c.out = (float*)d_out; c.ws = (char*)d_ws;
  int np = 0;
  bool x_in_out = false;
  auto add = [&](int op, int l, int half) {
    int rep = 1;
    if (op == OP_GEMM_W1) rep = REP_W1;
    if (op == OP_MIX_B) rep = half ? REP_MIXB2 : REP_MIXB;
    if (op == OP_PREP_C) rep = REP_C;
    if (op == OP_SCAN_C) rep = REP_SCAN;
    if (op == OP_ATTN_A) rep = REP_ATTN;
    if (op == OP_NORM_MLP || op == OP_NORM_MIX) rep = REP_NORM;
    for (int r = 0; r < rep; ++r) p.ops[np++] = (unsigned char)(op | (l << 4) | (half << 6) | (x_in_out ? 0 : 128));
    if (op == OP_GEMM_OUT || op == OP_GEMM_W2) x_in_out = true;
  };
  add(OP_CONVERT, 0, (MIXMASK & 1) ? 1 : 0);
#ifdef REP_SYNC
  for (int q = 0; q < REP_SYNC; ++q) p.ops[np++] = 15;
#endif
  for (int l = 0; l < 4; ++l) {
    const int kind = l % 3;
    if ((MIXMASK >> l) & 1) {
      add(OP_NORM_MIX, l, 0);
      if (kind == 0) { add(OP_GEMM_IN, l, 0); add(OP_ATTN_A, l, 0); add(OP_COMBINE_A, l, 0); add(OP_GEMM_OUT, l, 0); }
      else if (kind == 1) { add(OP_GEMM_IN, l, 0); add(OP_MIX_B, l, 0); add(OP_MIX_B, l, 1); add(OP_GEMM_OUT, l, 0); }
      else { add(OP_GEMM_IN, l, 0); add(OP_PREP_C, l, 0); add(OP_SCAN_GEMM, l, 0); add(OP_PREP_C, l, 1); add(OP_SCAN_C, l, 1); add(OP_OUTNORM_C, l, 0); add(OP_GEMM_OUT, l, 0); }
    }
    add(OP_NORM_MLP, l, 0); add(OP_GEMM_W1, l, 0); add(OP_GEMM_W2, l, 0);
  }
#if MULTI_LAUNCH
  for (int i = 0; i < np; ++i) {
    p.ph0 = i; p.ph1 = i + 1;
    hipLaunchKernelGGL(mega, dim3(grid_blocks), dim3(512), LDS_BYTES, stream, p);
  }
#else
  p.ph0 = 0; p.ph1 = np;
  (void)hipMemsetAsync((char*)d_ws + WS_BAR, 0, XCD_BAR_WORDS * 4, stream);
  void* args[] = {&p};
  hipError_t e = hipLaunchCooperativeKernel((const void*)mega, dim3(grid_blocks), dim3(512), args, LDS_BYTES, stream);
  if (e != hipSuccess) fprintf(stderr, "cooperative launch failed: %s (grid %d)\n", hipGetErrorString(e), grid_blocks);
#endif
}
```

```cpp
#include <hip/hip_runtime.h>
#include <hip/hip_cooperative_groups.h>
#include <stdint.h>
#include <cstdio>
namespace cg = cooperative_groups;

typedef unsigned short u16;
typedef __attribute__((ext_vector_type(8))) short bf16x8;
typedef __attribute__((ext_vector_type(4))) short s16x4;
typedef __attribute__((ext_vector_type(16))) float f32x16;
typedef __attribute__((ext_vector_type(4))) float f32x4;
#define DI __device__ __forceinline__
#define MFMA32(a, b, c) __builtin_amdgcn_mfma_f32_32x32x16_bf16((a), (b), (c), 0, 0, 0)
#define MFMA16(a, b, c) __builtin_amdgcn_mfma_f32_16x16x32_bf16((a), (b), (c), 0, 0, 0)

constexpr int NTOK = 32768, DM = 1024, SEQ = 4096;
constexpr size_t MiB = 1ull << 20;
constexpr size_t WS_WT = 0, WS_H = 102 * MiB, WS_P = 166 * MiB, WS_E = 454 * MiB, WS_LSE = 486 * MiB,
                 WS_SIDE = 489 * MiB, WS_STATE = 491 * MiB, WS_HALO = 495 * MiB, WS_GL = 495 * MiB + 512 * 1024,
                 WS_BAR = 495 * MiB + 768 * 1024, WS_END = 496 * MiB;
constexpr size_t WS_CQKV = WS_P, WS_CW = WS_P + 96 * MiB, WS_CU = WS_CW + 32 * MiB, WS_CQ = WS_CU + 32 * MiB,
                 WS_CKT = WS_CQ + 32 * MiB, WS_CQK = WS_CKT + 32 * MiB, WS_CG = WS_CQK + 16 * MiB;
static_assert(WS_CG + 64 * MiB <= WS_LSE, "layer C carve-out");
constexpr size_t WS_SEL = WS_P + 150 * MiB, WS_SELB = WS_P + 170 * MiB, WS_CNT = WS_P + 180 * MiB;
constexpr int HALF_LDS = 76800;
constexpr int LDS_BYTES = 2 * HALF_LDS + 16;

enum { OP_CONVERT = 0, OP_NORM_MIX, OP_GEMM_IN, OP_ATTN_A, OP_COMBINE_A, OP_GEMM_OUT, OP_MIX_B, OP_PREP_C, OP_SCAN_C,
       OP_OUTNORM_C, OP_NORM_MLP, OP_GEMM_W1, OP_GEMM_W2, OP_HEADNORM, OP_SCAN_GEMM };

struct Ctx {
  const float* x; const float* rel_bias; const float* norm_mix; const float* norm_mlp;
  const float* a_q_gain; const float* a_k_gain; const float* b_q_gain; const float* b_k_gain;
  const float* c_conv_w; const float* c_a_log; const float* c_dt_bias; const float* c_o_gain;
  const float* wbase[8];
  float* out; char* ws;
};
struct Params { Ctx c; int ph0; int ph1; unsigned char ops[64]; };

constexpr int cK[16] = {1024, 1024, 512, 512, 1024, 1024, 1024, 1024, 1024, 1024, 1024, 1024, 4096, 4096, 4096, 4096};
constexpr int cN[16] = {4608, 4608, 1024, 1024, 2120, 1024, 4112, 1024, 4096, 4096, 4096, 4096, 1024, 1024, 1024, 1024};
constexpr int cNpad[16] = {4608, 4608, 1024, 1024, 2304, 1024, 4352, 1024, 4096, 4096, 4096, 4096, 1024, 1024, 1024, 1024};
constexpr int cBase[16] = {0, 0, 1, 1, 2, 3, 4, 5, 6, 6, 6, 6, 7, 7, 7, 7};
constexpr unsigned cSrcOff[16] = {0, 1024u * 4608u, 0, 512u * 1024u, 0, 0, 0, 0, 0, 4194304u, 2u * 4194304u, 3u * 4194304u, 0, 4194304u, 2u * 4194304u, 3u * 4194304u};
constexpr unsigned wOff(int i) { unsigned o = 0; for (int k = 0; k < i; ++k) o += (unsigned)cK[k] * (unsigned)cNpad[k]; return o; }
constexpr int wTileStart(int i) { int o = 0; for (int k = 0; k < i; ++k) o += (cK[k] / 64) * (cNpad[k] / 64); return o; }
static_assert((size_t)wOff(16) * 2 <= 102 * MiB, "WT region");

template <class T> DI T* lau(T* x) { asm volatile("" : "+s"(x)); return x; }
template <class T> DI T* lauv(T* x) { asm volatile("" : "+v"(x)); return x; }
DI int tidx(int wv) {
  int w = wv;
  asm volatile("" : "+s"(w));
  int l = (int)__builtin_amdgcn_mbcnt_hi(~0u, __builtin_amdgcn_mbcnt_lo(~0u, 0u));
  asm volatile("" : "+v"(l));
  return (w << 6) | l;
}
DI int lane_now() { int l = (int)__builtin_amdgcn_mbcnt_hi(~0u, __builtin_amdgcn_mbcnt_lo(~0u, 0u)); asm volatile("" : "+v"(l)); return l; }
DI float shx(float v, int m) { return __int_as_float(__builtin_amdgcn_ds_bpermute((lane_now() ^ m) << 2, __float_as_int(v))); }
DI int shx(int v, int m) { return __builtin_amdgcn_ds_bpermute((lane_now() ^ m) << 2, v); }
DI float shidx(float v, int src) { return __int_as_float(__builtin_amdgcn_ds_bpermute(src << 2, __float_as_int(v))); }
DI int shidx(int v, int src) { return __builtin_amdgcn_ds_bpermute(src << 2, v); }
DI int shdown(int v, int d) { const int l = lane_now(); return __builtin_amdgcn_ds_bpermute((l + d < 64 ? l + d : l) << 2, v); }
DI float shup(float v, int d) { const int l = lane_now(); return __int_as_float(__builtin_amdgcn_ds_bpermute((l - d >= 0 ? l - d : l) << 2, __float_as_int(v))); }
typedef float f32x2_t __attribute__((ext_vector_type(2)));
typedef __bf16 bf16x2_t __attribute__((ext_vector_type(2)));
DI unsigned pk2bf(float lo, float hi) { const f32x2_t v = {lo, hi}; return __builtin_bit_cast(unsigned, __builtin_convertvector(v, bf16x2_t)); }
DI u16 f2bf(float x) { return (u16)(pk2bf(x, 0.f) & 0xffffu); }
DI float bf2f(u16 v) { return __uint_as_float(((unsigned)v) << 16); }
DI float bfs(short v) { return __uint_as_float(((unsigned)(u16)v) << 16); }
DI int crow(int i, int h) { return (i & 3) + 8 * (i >> 2) + 4 * h; }
DI int kpos(int d) { int e = d & 15; return (d & ~15) + ((e >> 2) & 1) * 8 + (e >> 3) * 4 + (e & 3); }
DI bf16x8 pack8(const f32x16& x, int s) {
  typedef unsigned u32x4_t __attribute__((ext_vector_type(4)));
  u32x4_t r;
  r[0] = pk2bf(x[8 * s + 0], x[8 * s + 1]); r[1] = pk2bf(x[8 * s + 2], x[8 * s + 3]);
  r[2] = pk2bf(x[8 * s + 4], x[8 * s + 5]); r[3] = pk2bf(x[8 * s + 6], x[8 * s + 7]);
  return __builtin_bit_cast(bf16x8, r);
}
DI f32x16 zero16() { f32x16 z;
#pragma unroll
  for (int i = 0; i < 16; ++i) z[i] = 0.f; return z; }
DI bf16x8 zero8() { int zz = 0; asm volatile("" : "+v"(zz)); bf16x8 z;
#pragma unroll
  for (int i = 0; i < 8; ++i) z[i] = (short)zz; return z; }
DI int t5_bucket(int dist) {
  if (dist < 16) return dist;
  float lp = logf((float)dist / 16.0f) / 4.852030263919617f * 16.0f;
  int b = 16 + (int)lp;
  return b < 31 ? b : 31;
}

namespace pg8 {
#define PG8_LAS __attribute__((address_space(3)))
typedef unsigned short bf16_t;
typedef short bf16x8 __attribute__((ext_vector_type(8)));
typedef float f32x4 __attribute__((ext_vector_type(4)));
typedef unsigned u32x4 __attribute__((ext_vector_type(4)));
constexpr int BM = 256, BK = 64, HALF = 128, HTB = HALF * BK * 2  , STAGE_BYTES = 8 * HTB, NXCD = 8, WGM = 8;

__host__ __device__ __forceinline__ int lds_byte(int r, int c) { const int st = (r >> 4) * 2 + (c >> 5), rr = r & 15, cc = c & 31, ob = rr * 64 + cc * 2; return st * 1024 + (ob ^ (((ob >> 9) & 1) << 5)); }
__host__ __device__ __forceinline__ void stage_rc(int b, int& R, int& C) { const int st = b / 1024, sb = b % 1024, swz = sb ^ (((sb >> 9) & 1) << 5); R = (st >> 1) * 16 + swz / 64; C = (st & 1) * 32 + (swz % 64) / 2; }
__host__ __device__ __forceinline__ int perm32(int rho) { const int n = rho >> 4, i = rho & 15; return 8 * (i >> 2) + 4 * n + (i & 3); }

struct Unit { int pm, pn; };
struct Gemm { const bf16_t* A; const bf16_t* Bt; int M, N, K; int half; };
__device__ __forceinline__ size_t a_tile_row(const Gemm& g, int pm) { return g.half < 0 ? (size_t)pm * 256 : (size_t)(pm >> 3) * 4096 + (size_t)g.half * 2048 + (size_t)(pm & 7) * 256; }

struct StaticOrder {
    int nM, nN, nwg, G, c;
    __host__ __device__ void init(int M, int N, int G_, int c_) { nM = M / BM; nN = N / BM; nwg = nM * nN; G = G_; c = c_; }
    __host__ __device__ bool next(int i, Unit& u) const {
        const long L = (long)i * G + c; if (L >= nwg) return false;
        int wgid = (int)L; { const int q = nwg / NXCD, r = nwg % NXCD, xcd = wgid % NXCD, off = wgid / NXCD; wgid = (xcd < r ? xcd * (q + 1) : r * (q + 1) + (xcd - r) * q) + off; }
        const int nig = WGM * nN, gid = wgid / nig, fm = gid * WGM, gsz = (nM - fm) < WGM ? (nM - fm) : WGM;
        u.pm = fm + ((wgid % nig) % gsz); u.pn = (wgid % nig) / gsz; return true;
    }
    __device__ __forceinline__ void a_ready(const Unit&) const {}
    __device__ __forceinline__ void done(const Unit&) const {}
};
__device__ __forceinline__ unsigned cvt_pk_bf16(float lo, float hi) { unsigned r; asm volatile("v_cvt_pk_bf16_f32 %0, %1, %2" : "=v"(r) : "v"(lo), "v"(hi)); return r; }
template <class Epi, class Sched>
__device__ __forceinline__ void gemm_phase(PG8_LAS unsigned char* lds, const Gemm g, const Sched& S, const Epi& E, const int tid) {
    const int wid = __builtin_amdgcn_readfirstlane(tid >> 6), lane = tid & 63, wr = wid >> 2, wc = wid & 3, fr = lane & 15, fq = lane >> 4;
    const int K = g.K, nt = K / BK;
    unsigned voffA[2], voffB[2];
#pragma unroll
    for (int i = 0; i < 2; ++i) { int R, C; stage_rc(tid * 16 + i * 8192, R, C); const int Rb = Epi::PERM ? ((R & ~31) + perm32(R & 31)) : R;
        voffA[i] = (unsigned)(R * K + C) * 2u; voffB[i] = (unsigned)(Rb * K + C) * 2u; }
    const size_t kstep = (size_t)(BK * 2);
    const size_t hstep = (size_t)HALF * K * 2;
    const size_t tstep = 2 * hstep;
    const unsigned ldsw = (unsigned)wid * 1024u;
    const int aoff = lds_byte(wr * 64 + fr, fq * 8), boff = lds_byte(wc * 32 + fr, fq * 8);
#define PG8_SA(b, h) (((b) * 2 + (h)) * HTB)
#define PG8_SB(b, h) ((4 + (b) * 2 + (h)) * HTB)
#define PG8_STAGE(bufoff, gbase, voff) do { _Pragma("unroll") for (int _i = 0; _i < 2; ++_i) \
        __builtin_amdgcn_global_load_lds((const unsigned*)((const char*)(gbase) + (voff)[_i]), (PG8_LAS unsigned*)(lds + (bufoff) + ldsw + _i * 8192), 16, 0, 0); } while (0)
#define PG8_LDA(dst, b, h) do { _Pragma("unroll") for (int m = 0; m < 4; ++m) _Pragma("unroll") for (int k = 0; k < 2; ++k) dst[m][k] = *(const PG8_LAS bf16x8*)(lds + PG8_SA(b, h) + aoff + m * 2048 + k * 1024); } while (0)
#define PG8_LDB(dst, b, h) do { _Pragma("unroll") for (int n = 0; n < 2; ++n) _Pragma("unroll") for (int k = 0; k < 2; ++k) dst[n][k] = *(const PG8_LAS bf16x8*)(lds + PG8_SB(b, h) + boff + n * 2048 + k * 1024); } while (0)
#define PG8_MMA(ai, bj, At, Bt) do { __builtin_amdgcn_s_setprio(1); _Pragma("unroll") for (int m = 0; m < 4; ++m) _Pragma("unroll") for (int n = 0; n < 2; ++n) _Pragma("unroll") for (int k = 0; k < 2; ++k) \
        acc[ai][bj][m][n] = __builtin_amdgcn_mfma_f32_16x16x32_bf16(Bt[n][k], At[m][k], acc[ai][bj][m][n], 0, 0, 0); __builtin_amdgcn_s_setprio(0); } while (0)
#define PG8_WAIT_V(n) asm volatile("s_waitcnt vmcnt(" #n ")" ::: "memory")
#define PG8_WAIT_L(n) asm volatile("s_waitcnt lgkmcnt(" #n ")" ::: "memory")
#define PG8_BAR __builtin_amdgcn_s_barrier()
#define PG8_SCHED __builtin_amdgcn_sched_barrier(0)
    Unit cur, nxt; int ui = 0;
    if (!S.next(0, cur)) return;
    f32x4 acc[2][2][4][2];
#pragma unroll
    for (int a = 0; a < 2; ++a)
#pragma unroll
        for (int b = 0; b < 2; ++b)
#pragma unroll
            for (int m = 0; m < 4; ++m)
#pragma unroll
                for (int n = 0; n < 2; ++n) acc[a][b][m][n] = (f32x4){0.f, 0.f, 0.f, 0.f};
    bf16x8 At[4][2], B0[2][2], B1[2][2];
    const char* cA = (const char*)g.A + a_tile_row(g, cur.pm) * (size_t)K * 2; const char* cB = (const char*)g.Bt + (size_t)cur.pn * tstep;
    S.a_ready(cur);
    PG8_STAGE(PG8_SB(0, 0), cB, voffB); PG8_STAGE(PG8_SA(0, 0), cA, voffA); PG8_STAGE(PG8_SB(0, 1), cB + hstep, voffB); PG8_STAGE(PG8_SA(0, 1), cA + hstep, voffA);
    if (wr == 1) PG8_BAR;
    PG8_WAIT_V(4); PG8_BAR;
    PG8_STAGE(PG8_SB(1, 0), cB + kstep, voffB); PG8_STAGE(PG8_SA(1, 0), cA + kstep, voffA); PG8_STAGE(PG8_SB(1, 1), cB + hstep + kstep, voffB);
    PG8_WAIT_V(6); PG8_BAR;
    for (;;) {
        const bool has_next = S.next(ui + 1, nxt);
        const char* nA = has_next ? (const char*)g.A + a_tile_row(g, nxt.pm) * (size_t)K * 2 : cA; const char* nB = has_next ? (const char*)g.Bt + (size_t)nxt.pn * tstep : cB;
        for (int t = 0; t < nt; t += 2) {
            const bool last = (t == nt - 2);
            const char* a1 = cA + (size_t)(t + 1) * kstep;
            const char* a2 = last ? nA : cA + (size_t)(t + 2) * kstep; const char* b2 = last ? nB : cB + (size_t)(t + 2) * kstep;
            const char* a3 = a2 + kstep; const char* b3 = b2 + kstep;
            if (last && has_next) S.a_ready(nxt);
            PG8_LDB(B0, 0, 0); PG8_SCHED; PG8_LDA(At, 0, 0); PG8_STAGE(PG8_SA(1, 1), a1 + hstep, voffA);
            PG8_WAIT_L(8); PG8_BAR; PG8_WAIT_L(0); PG8_MMA(0, 0, At, B0); PG8_BAR; PG8_SCHED;
            PG8_LDB(B1, 0, 1); PG8_STAGE(PG8_SB(0, 0), b2, voffB);
            PG8_BAR; PG8_WAIT_L(0); PG8_MMA(0, 1, At, B1); PG8_BAR;
            PG8_LDA(At, 0, 1); PG8_STAGE(PG8_SA(0, 0), a2, voffA);
            PG8_BAR; PG8_WAIT_L(0); PG8_MMA(1, 0, At, B0); PG8_BAR; PG8_SCHED;
            PG8_STAGE(PG8_SB(0, 1), b2 + hstep, voffB);
            PG8_WAIT_V(6); PG8_BAR; PG8_MMA(1, 1, At, B1); PG8_BAR;
            PG8_LDB(B0, 1, 0); PG8_SCHED; PG8_LDA(At, 1, 0); PG8_STAGE(PG8_SA(0, 1), a2 + hstep, voffA);
            PG8_WAIT_L(8); PG8_BAR; PG8_WAIT_L(0); PG8_MMA(0, 0, At, B0); PG8_BAR; PG8_SCHED;
            PG8_LDB(B1, 1, 1); PG8_STAGE(PG8_SB(1, 0), b3, voffB);
            PG8_BAR; PG8_WAIT_L(0); PG8_MMA(0, 1, At, B1); PG8_BAR;
            PG8_LDA(At, 1, 1); PG8_STAGE(PG8_SA(1, 0), a3, voffA);
            PG8_BAR; PG8_WAIT_L(0); PG8_MMA(1, 0, At, B0); PG8_BAR; PG8_SCHED;
            PG8_STAGE(PG8_SB(1, 1), b3 + hstep, voffB);
            PG8_WAIT_V(6); PG8_BAR; PG8_MMA(1, 1, At, B1); PG8_BAR;
        }
        if constexpr (!Epi::AFTER_DRAIN) { E(acc, cur, wr, wc, fr, fq); S.done(cur); }
        if (!has_next) break;
#pragma unroll
        for (int a = 0; a < 2; ++a)
#pragma unroll
            for (int b = 0; b < 2; ++b)
#pragma unroll
                for (int m = 0; m < 4; ++m)
#pragma unroll
                    for (int n = 0; n < 2; ++n) acc[a][b][m][n] = (f32x4){0.f, 0.f, 0.f, 0.f};
        cur = nxt; cA = nA; cB = nB; ++ui;
    }
    PG8_WAIT_V(0);
    if (wr == 0) PG8_BAR;
    PG8_BAR;
    if constexpr (Epi::AFTER_DRAIN) { E.fused(acc, cur, wr, wc, fr, fq, lds, wid, lane); S.done(cur); }
#undef PG8_SA
#undef PG8_SB
#undef PG8_STAGE
#undef PG8_LDA
#undef PG8_LDB
#undef PG8_MMA
#undef PG8_WAIT_V
#undef PG8_WAIT_L
#undef PG8_BAR
#undef PG8_SCHED
}
}


namespace pg8 {
template <int ACT> struct EpiB16 {
    static constexpr bool PERM = true, AFTER_DRAIN = false;
    bf16_t* O; int ldc;
    __device__ __forceinline__ void operator()(const f32x4 (&acc)[2][2][4][2], const Unit& u, int wr, int wc, int fr, int fq) const {
        const int row0 = u.pm * BM + wr * 64 + fr, col0 = u.pn * BM + wc * 32 + 8 * fq;
#pragma unroll
        for (int ai = 0; ai < 2; ++ai)
#pragma unroll
            for (int m = 0; m < 4; ++m) { bf16_t* rowp = O + (size_t)(row0 + ai * HALF + m * 16) * ldc + col0;
#pragma unroll
                for (int bj = 0; bj < 2; ++bj) { f32x4 v0 = acc[ai][bj][m][0], v1 = acc[ai][bj][m][1];
                    if (ACT == 1) {
#pragma unroll
                        for (int j = 0; j < 4; ++j) { float a = v0[j] > 0.f ? v0[j] : 0.f, b = v1[j] > 0.f ? v1[j] : 0.f; v0[j] = a * a; v1[j] = b * b; } }
                    u32x4 w; w.x = cvt_pk_bf16(v0[0], v0[1]); w.y = cvt_pk_bf16(v0[2], v0[3]); w.z = cvt_pk_bf16(v1[0], v1[1]); w.w = cvt_pk_bf16(v1[2], v1[3]);
                    *(u32x4*)(rowp + bj * HALF) = w; } }
    }
};
struct EpiB16HN {
    static constexpr bool PERM = true, AFTER_DRAIN = false;
    bf16_t* O; int ldc; int ncols_norm, nq_cols; const float* gq; const float* gk; PG8_LAS float* T;
    __device__ __forceinline__ void operator()(const f32x4 (&acc)[2][2][4][2], const Unit& u, int wr, int wc, int fr, int fq) const {
        const int row0 = u.pm * BM + wr * 64 + fr, col0 = u.pn * BM + wc * 32 + 8 * fq;
        const bool hn = u.pn * BM < ncols_norm;
        float part[2][4][2];
        if (hn) {
#pragma unroll
            for (int ai = 0; ai < 2; ++ai)
#pragma unroll
                for (int m = 0; m < 4; ++m)
#pragma unroll
                    for (int bj = 0; bj < 2; ++bj) { const f32x4 a = acc[ai][bj][m][0], b = acc[ai][bj][m][1];
                        float sq = a[0] * a[0] + a[1] * a[1] + a[2] * a[2] + a[3] * a[3] + b[0] * b[0] + b[1] * b[1] + b[2] * b[2] + b[3] * b[3];
                        sq += shx(sq, 16); sq += shx(sq, 32); part[ai][m][bj] = sq; }
            PG8_LAS float* mine = T + ((wr * 4 + wc) * 16) * 16 + fr;
            if (fq == 0) {
#pragma unroll
                for (int ai = 0; ai < 2; ++ai)
#pragma unroll
                    for (int m = 0; m < 4; ++m)
#pragma unroll
                        for (int bj = 0; bj < 2; ++bj) mine[((ai * 4 + m) * 2 + bj) * 16] = part[ai][m][bj];
            }
            asm volatile("s_waitcnt lgkmcnt(0)" ::: "memory");
            __builtin_amdgcn_s_barrier();
            const PG8_LAS float* other = T + ((wr * 4 + (wc ^ 1)) * 16) * 16 + fr;
#pragma unroll
            for (int ai = 0; ai < 2; ++ai)
#pragma unroll
                for (int m = 0; m < 4; ++m)
#pragma unroll
                    for (int bj = 0; bj < 2; ++bj) part[ai][m][bj] += other[((ai * 4 + m) * 2 + bj) * 16];
        }
        const bool isq = u.pn * BM < nq_cols;
        const float* gp = (isq ? gq : gk) + ((wc & 1) * 32 + 8 * fq);
        const float qs = isq ? 0.125f * 1.4426950408889634f : 1.0f;
        float g8[8];
#pragma unroll
        for (int j = 0; j < 8; ++j) g8[j] = hn ? gp[j] * qs : 1.0f;
#pragma unroll
        for (int ai = 0; ai < 2; ++ai)
#pragma unroll
            for (int m = 0; m < 4; ++m) { bf16_t* rowp = O + (size_t)(row0 + ai * HALF + m * 16) * ldc + col0;
#pragma unroll
                for (int bj = 0; bj < 2; ++bj) { f32x4 v0 = acc[ai][bj][m][0], v1 = acc[ai][bj][m][1];
                    const float r = hn ? rsqrtf(part[ai][m][bj] * (1.0f / 64.0f) + 1e-6f) : 1.0f;
#pragma unroll
                    for (int j = 0; j < 4; ++j) { v0[j] *= r * g8[j]; v1[j] *= r * g8[4 + j]; }
                    u32x4 w; w.x = cvt_pk_bf16(v0[0], v0[1]); w.y = cvt_pk_bf16(v0[2], v0[3]); w.z = cvt_pk_bf16(v1[0], v1[1]); w.w = cvt_pk_bf16(v1[2], v1[3]);
                    *(u32x4*)(rowp + bj * HALF) = w; } }
    }
};
struct EpiResid {
    static constexpr bool PERM = false, AFTER_DRAIN = false;
    float* C; const float* X;
    __device__ __forceinline__ void operator()(const f32x4 (&acc)[2][2][4][2], const Unit& u, int wr, int wc, int fr, int fq) const {
        const int row0 = u.pm * BM + wr * 64 + fr, col0 = u.pn * BM + wc * 32 + 4 * fq;
#pragma unroll
        for (int ai = 0; ai < 2; ++ai) {
            f32x4 xv[4][2][2];
#pragma unroll
            for (int m = 0; m < 4; ++m)
#pragma unroll
                for (int bj = 0; bj < 2; ++bj)
#pragma unroll
                    for (int n = 0; n < 2; ++n) xv[m][bj][n] = *(const f32x4*)(X + (size_t)(row0 + ai * HALF + m * 16) * 1024 + col0 + bj * HALF + n * 16);
#pragma unroll
            for (int m = 0; m < 4; ++m)
#pragma unroll
                for (int bj = 0; bj < 2; ++bj)
#pragma unroll
                    for (int n = 0; n < 2; ++n) *(f32x4*)(C + (size_t)(row0 + ai * HALF + m * 16) * 1024 + col0 + bj * HALF + n * 16) = xv[m][bj][n] + acc[ai][bj][m][n];
        }
    }
};
struct EpiCIn {
    static constexpr bool PERM = true, AFTER_DRAIN = false;
    bf16_t* Q; bf16_t* G; float* S; int half;
    __device__ __forceinline__ void operator()(const f32x4 (&acc)[2][2][4][2], const Unit& u, int wr, int wc, int fr, int fq) const {
        const int rl0 = wr * 64 + fr, cl0 = wc * 32 + 8 * fq;
        const size_t crow0 = (size_t)u.pm * 256, arow0 = (size_t)(u.pm >> 3) * 4096 + (size_t)half * 2048 + (size_t)(u.pm & 7) * 256;
#pragma unroll
        for (int ai = 0; ai < 2; ++ai)
#pragma unroll
            for (int m = 0; m < 4; ++m) { const int rl = rl0 + ai * HALF + m * 16;
#pragma unroll
                for (int bj = 0; bj < 2; ++bj) { const f32x4 v0 = acc[ai][bj][m][0], v1 = acc[ai][bj][m][1]; const int cl = cl0 + bj * HALF;
                    if (u.pn < 16) {
                        u32x4 w; w.x = cvt_pk_bf16(v0[0], v0[1]); w.y = cvt_pk_bf16(v0[2], v0[3]); w.z = cvt_pk_bf16(v1[0], v1[1]); w.w = cvt_pk_bf16(v1[2], v1[3]);
                        if (u.pn < 12) *(u32x4*)(Q + (crow0 + rl) * 3072 + u.pn * 256 + cl) = w;
                        else *(u32x4*)(G + (arow0 + rl) * 1024 + (u.pn - 12) * 256 + cl) = w;
                    } else if (cl < 16) { float* sp = S + (arow0 + rl) * 16 + cl; *(f32x4*)sp = v0; *(f32x4*)(sp + 4) = v1; } } }
    }
};
}

struct CvtTile { const float* src; int K, N, k0, n0; unsigned off; };
DI CvtTile cvt_locate(const Ctx& p, int t) {
  int K = cK[0], N = cN[0], base = 0; unsigned off = 0, soff = 0; int bi = 0;
#define WSEL(i) if (t >= wTileStart(i)) { K = cK[i]; N = cN[i]; base = wTileStart(i); off = wOff(i); soff = cSrcOff[i]; bi = cBase[i]; }
  WSEL(1) WSEL(2) WSEL(3) WSEL(4) WSEL(5) WSEL(6) WSEL(7) WSEL(8) WSEL(9) WSEL(10) WSEL(11) WSEL(12) WSEL(13) WSEL(14) WSEL(15)
#undef WSEL
  const float* src = p.wbase[0];
#pragma unroll
  for (int q = 1; q < 8; ++q) if (bi == q) src = p.wbase[q];
  const int lt = t - base, nkt = K / 64;
  CvtTile c; c.src = src + soff; c.K = K; c.N = N; c.k0 = (lt % nkt) * 64; c.n0 = (lt / nkt) * 64; c.off = off;
  return c;
}
DI void phase_convert(int wv_, int vb_, int nvb_, char* ws_, const Ctx& p, char* smem) {
  float* tile = (float*)smem;
  const int tid = tidx(wv_);
  const int ty = tid >> 4, tx = tid & 15;
  constexpr int total = wTileStart(16);
  const int trips_ = (total + nvb_ - 1) / nvb_;
#define CVT_LOAD(C, V) { _Pragma("unroll") for (int i = 0; i < 4; ++i) { const int n_ = (C).n0 + tx * 4; \
    V[i] = (n_ < (C).N) ? *(const float4*)((C).src + (size_t)((C).k0 + ty + 16 * i) * (C).N + n_) : make_float4(0.f, 0.f, 0.f, 0.f); } }
  CvtTile cur = cvt_locate(p, (vb_ < total) ? vb_ : total - 1);
  float4 v[4];
  CVT_LOAD(cur, v)
  for (int k_ = 0; k_ < trips_; ++k_) {
    const int tn = vb_ + (k_ + 1) * nvb_;
    const CvtTile nxt = cvt_locate(p, (tn < total) ? tn : total - 1);
    float4 vn[4];
    CVT_LOAD(nxt, vn)
#pragma unroll
    for (int i = 0; i < 4; ++i) { float* d = tile + (ty + 16 * i) * 65 + tx * 4; d[0] = v[i].x; d[1] = v[i].y; d[2] = v[i].z; d[3] = v[i].w; }
    __syncthreads();
    {
      const int n = tid >> 2, kq = tid & 3;
      bf16x8 o0, o1;
#pragma unroll
      for (int j = 0; j < 8; ++j) { o0[j] = (short)f2bf(tile[(kq * 16 + j) * 65 + n]); o1[j] = (short)f2bf(tile[(kq * 16 + 8 + j) * 65 + n]); }
      u16* dst = (u16*)(ws_ + WS_WT) + (size_t)cur.off + (size_t)(cur.n0 + n) * cur.K + cur.k0 + kq * 16;
      *(bf16x8*)dst = o0; *(bf16x8*)(dst + 8) = o1;
    }
    __syncthreads();
    cur = nxt;
#pragma unroll
    for (int i = 0; i < 4; ++i) v[i] = vn[i];
  }
#undef CVT_LOAD
}

DI void phase_norm(int wv_, int vb_, int nvb_, const float* x, const float* gain, u16* H) {
  const int tid = tidx(wv_); const int lane = tid & 63, wave = tid >> 6;
  float4 g[4];
#pragma unroll
  for (int c = 0; c < 4; ++c) g[c] = ((const float4*)gain)[c * 64 + lane];
  for (int row0 = (vb_ * 4 + wave) * 4; row0 < NTOK; row0 += nvb_ * 16) {
    float4 v[4][4]; float ss[4];
#pragma unroll
    for (int r = 0; r < 4; ++r) {
      const float4* xr = (const float4*)(x + (size_t)(row0 + r) * DM);
#pragma unroll
      for (int c = 0; c < 4; ++c) v[r][c] = xr[c * 64 + lane];
    }
#pragma unroll
    for (int r = 0; r < 4; ++r) { float a = 0.f;
#pragma unroll
      for (int c = 0; c < 4; ++c) a += v[r][c].x * v[r][c].x + v[r][c].y * v[r][c].y + v[r][c].z * v[r][c].z + v[r][c].w * v[r][c].w;
      ss[r] = a; }
#pragma unroll
    for (int o = 1; o < 64; o <<= 1) {
#pragma unroll
      for (int r = 0; r < 4; ++r) ss[r] += shx(ss[r], o);
    }
#pragma unroll
    for (int r = 0; r < 4; ++r) {
      const float rr = rsqrtf(ss[r] * (1.0f / DM) + 1e-6f);
#pragma unroll
      for (int c = 0; c < 4; ++c) {
        s16x4 o; o[0] = (short)f2bf(v[r][c].x * rr * g[c].x); o[1] = (short)f2bf(v[r][c].y * rr * g[c].y); o[2] = (short)f2bf(v[r][c].z * rr * g[c].z); o[3] = (short)f2bf(v[r][c].w * rr * g[c].w);
        *(s16x4*)(H + (size_t)(row0 + r) * DM + (c * 64 + lane) * 4) = o;
      }
    }
  }
}

DI void phase_headnorm(int wv_, int vb_, int nvb_, u16* P, int ld, int nheads, int nq, const float* gq, const float* gk) {
  const int tid = tidx(wv_);
  const int part = tid & 7;
  const size_t total = (size_t)NTOK * nheads * 8;
  for (size_t idx = (size_t)vb_ * 256 + tid; idx < total; idx += (size_t)nvb_ * 256) {
    const size_t rh = idx >> 3; const size_t row = rh / nheads; const int head = (int)(rh - row * nheads);
    u16* pp = P + row * ld + head * 64 + part * 8;
    bf16x8 v = *(const bf16x8*)pp;
    float f[8]; float ss = 0.f;
#pragma unroll
    for (int j = 0; j < 8; ++j) { f[j] = bfs(v[j]); ss += f[j] * f[j]; }
    ss += shx(ss, 1); ss += shx(ss, 2); ss += shx(ss, 4);
    const float rn = rsqrtf(ss * (1.0f / 64.0f) + 1e-6f) * (head < nq ? 0.125f : 1.0f);
    const float* g = (head < nq ? gq : gk) + part * 8;
    bf16x8 o;
#pragma unroll
    for (int j = 0; j < 8; ++j) o[j] = (short)f2bf(f[j] * rn * g[j]);
    *(bf16x8*)pp = o;
  }
}

DI void phase_attn_a(int wv_, int vb_, int nvb_, char* ws_, const Ctx& p, char* smem) {
  u16* Vt = (u16*)smem;
  float* sBias = (float*)(smem + 64 * 260 * 2);
  const u16* P = (const u16*)(ws_ + WS_P);
  const int tid = tidx(wv_), lane = tid & 63, wave = tid >> 6, c = lane & 31, h = lane >> 5;
  for (int k_ = 0; k_ < (6144 + nvb_ - 1) / nvb_; ++k_) {
    const int u = (vb_ + k_ * nvb_ < 6144) ? vb_ + k_ * nvb_ : 6143;
    const int head = u & 7, g = (u >> 3) % 3, rest = u / 24, idx = rest & 31, b = rest >> 5;
    const int dil = (g == 0) ? 1 : ((g == 1) ? 4 : 16);
    const int nbper = 32 / dil, r = idx / nbper, nb = idx % nbper;
    u16* Og = (g == 0) ? (u16*)(ws_ + WS_H) : ((g == 1) ? (u16*)(ws_ + WS_H + 32 * MiB) : (u16*)(ws_ + WS_E));
    float* lse = (float*)(ws_ + WS_LSE) + (size_t)g * NTOK * 8;
    if (tid <= 128) sBias[tid] = p.rel_bias[t5_bucket(tid * dil) * 40 + g * 8 + head] * 1.4426950408889634f;
    {
      const int kk = tid; const int ksub = nb * 128 - 128 + kk;
      bf16x8 v[8];
      if (ksub >= 0) {
        const u16* vp = P + ((size_t)b * SEQ + (size_t)ksub * dil + r) * 4608 + 3072 + g * 512 + head * 64;
#pragma unroll
        for (int i = 0; i < 8; ++i) v[i] = *(const bf16x8*)(vp + i * 8);
      } else {
#pragma unroll
        for (int i = 0; i < 8; ++i) v[i] = zero8();
      }
#pragma unroll
      for (int i = 0; i < 8; ++i)
#pragma unroll
        for (int jj = 0; jj < 8; ++jj) Vt[(i * 8 + jj) * 260 + kk] = (u16)v[i][jj];
    }
    __syncthreads();
    {
      const int qi = 32 * wave + c;
      const int qtok = (nb * 128 + qi) * dil + r;
      const u16* qp = P + ((size_t)b * SEQ + qtok) * 4608 + g * 512 + head * 64;
      bf16x8 qf[4];
#pragma unroll
      for (int ks = 0; ks < 4; ++ks) qf[ks] = *(const bf16x8*)(qp + ks * 16 + h * 8);
      float mx = -INFINITY, sum = 0.f;
      f32x16 oacc[2]; oacc[0] = zero16(); oacc[1] = zero16();
#pragma unroll 1
      for (int kb = 0; kb < 5; ++kb) {
        const int kk = 32 * wave + 32 * kb + c; const int ksub0 = nb * 128 - 128 + kk;
        bf16x8 kf[4];
        if (ksub0 >= 0) {
          const u16* kp = P + ((size_t)b * SEQ + (size_t)ksub0 * dil + r) * 4608 + 1536 + g * 512 + head * 64;
#pragma unroll
          for (int ks = 0; ks < 4; ++ks) kf[ks] = *(const bf16x8*)(kp + ks * 16 + h * 8);
        } else {
#pragma unroll
          for (int ks = 0; ks < 4; ++ks) kf[ks] = zero8();
        }
        f32x16 sa = zero16();
#pragma unroll
        for (int ks = 0; ks < 4; ++ks) sa = MFMA32(kf[ks], qf[ks], sa);
        float bm = -INFINITY;
        const int sbase = c + 128 - 32 * kb - 4 * h;
        const unsigned slim = (unsigned)((nb * 128 + 32 * wave + c) < 128 ? (nb * 128 + 32 * wave + c) : 128);
        if (nb > 0 && kb >= 1 && kb <= 3) {
#pragma unroll
          for (int i = 0; i < 16; ++i) {
            const int step = sbase - ((i & 3) + 8 * (i >> 2));
            const float v = sa[i] + sBias[step];
            sa[i] = v; bm = fmaxf(bm, v);
          }
        } else {
#pragma unroll
          for (int i = 0; i < 16; ++i) {
            const int step = sbase - ((i & 3) + 8 * (i >> 2));
            const bool valid = (unsigned)step <= slim;
            const float bv = sBias[step];
            float v = valid ? sa[i] + bv : -INFINITY;
            sa[i] = v; bm = fmaxf(bm, v);
          }
        }
        bm = fmaxf(bm, shx(bm, 32));
        const float mnew = fmaxf(mx, bm);
        const float mref = (mnew == -INFINITY) ? 0.f : mnew;
        const float scale = __builtin_amdgcn_exp2f(mx - mref);
        float ps = 0.f;
#pragma unroll
        for (int i = 0; i < 16; ++i) { float pv = __builtin_amdgcn_exp2f(sa[i] - mref); sa[i] = pv; ps += pv; }
        sum = sum * scale + ps; mx = mnew;
#pragma unroll
        for (int i = 0; i < 16; ++i) { oacc[0][i] *= scale; oacc[1][i] *= scale; }
#pragma unroll
        for (int s = 0; s < 2; ++s) {
          bf16x8 pb = pack8(sa, s);
          const int keybase = 32 * wave + 32 * kb + 16 * s;
#pragma unroll
          for (int mb = 0; mb < 2; ++mb) {
            const u16* vr = Vt + (mb * 32 + c) * 260 + keybase + 4 * h;
            s16x4 lo = *(const s16x4*)vr, hi = *(const s16x4*)(vr + 8);
            bf16x8 va = __builtin_shufflevector(lo, hi, 0, 1, 2, 3, 4, 5, 6, 7);
            oacc[mb] = MFMA32(va, pb, oacc[mb]);
          }
        }
      }
      sum += shx(sum, 32);
      const float inv = 1.0f / sum;
      u16* op = Og + ((size_t)b * SEQ + qtok) * 512 + head * 64;
#pragma unroll
      for (int mb = 0; mb < 2; ++mb)
#pragma unroll
        for (int ig = 0; ig < 4; ++ig) {
          s16x4 o;
#pragma unroll
          for (int q = 0; q < 4; ++q) o[q] = (short)f2bf(oacc[mb][ig * 4 + q] * inv);
          *(s16x4*)(op + mb * 32 + 8 * ig + 4 * h) = o;
        }
      if (h == 0) lse[((size_t)b * SEQ + qtok) * 8 + head] = (mx + log2f(sum)) * 0.6931471805599453f;
    }
    __syncthreads();
  }
}

DI void phase_combine_a(int wv_, int vb_, int nvb_, char* ws_, const Ctx& p) {
  u16* O0 = (u16*)(ws_ + WS_H); const u16* O1 = (const u16*)(ws_ + WS_H + 32 * MiB); const u16* O2 = (const u16*)(ws_ + WS_E);
  const float* lse = (const float*)(ws_ + WS_LSE);
  const int tid = tidx(wv_);
  const size_t stride = (size_t)nvb_ * 256, total = (size_t)NTOK * 64;
  for (size_t idx0 = (size_t)vb_ * 256 + tid; idx0 < total; idx0 += 4 * stride) {
    bf16x8 a[4], b[4], cc[4]; float l0[4], l1[4], l2[4]; bool ok[4];
#pragma unroll
    for (int q = 0; q < 4; ++q) {
      const size_t idx = idx0 + q * stride; ok[q] = idx < total; const size_t ix = ok[q] ? idx : idx0;
      const size_t tok = ix >> 6; const int head = (ix >> 3) & 7;
      l0[q] = lse[tok * 8 + head]; l1[q] = lse[(size_t)NTOK * 8 + tok * 8 + head]; l2[q] = lse[(size_t)2 * NTOK * 8 + tok * 8 + head];
      a[q] = *(const bf16x8*)(O0 + ix * 8); b[q] = *(const bf16x8*)(O1 + ix * 8); cc[q] = *(const bf16x8*)(O2 + ix * 8);
    }
#pragma unroll
    for (int q = 0; q < 4; ++q) {
      const float m = fmaxf(l0[q], fmaxf(l1[q], l2[q]));
      float e0 = __expf(l0[q] - m), e1 = __expf(l1[q] - m), e2 = __expf(l2[q] - m);
      const float inv = 1.0f / (e0 + e1 + e2); e0 *= inv; e1 *= inv; e2 *= inv;
      bf16x8 o;
#pragma unroll
      for (int j = 0; j < 8; ++j) o[j] = (short)f2bf(e0 * bfs(a[q][j]) + e1 * bfs(b[q][j]) + e2 * bfs(cc[q][j]));
      if (ok[q]) *(bf16x8*)(O0 + (idx0 + q * stride) * 8) = o;
    }
  }
}

DI unsigned hkey(float s) {
  if (s == 0.f) s = 0.f;
  const _Float16 hv = (_Float16)s;
  const unsigned u = (unsigned)__builtin_bit_cast(unsigned short, hv);
  return (u & 0x8000u) ? (~u & 0xffffu) : (u | 0x8000u);
}

DI void phase_mix_b(int wv_, int vb_, int nvb_, char* ws_, const Ctx& p, char* smem) {
  u16* sc = (u16*)smem;
  unsigned* hist = (unsigned*)(smem + 65536);
  u16* sel = (u16*)(smem + 65536 + 4096);
  const u16* P = (const u16*)(ws_ + WS_P);
  for (int k_ = 0; k_ < (4096 + nvb_ - 1) / nvb_; ++k_) {
    const int it = (vb_ + k_ * nvb_ < 4096) ? vb_ + k_ * nvb_ : 4095;
    const int b = it & 7, qt = 511 - (it >> 3), t0 = qt * 8;
    const u16* Pb = P + (size_t)b * SEQ * 2304;
    {
      const int tid1 = tidx(wv_); const int c = tid1 & 31, h = (tid1 >> 5) & 1, wave = tid1 >> 6;
      const int hd = (c & 3) + 4 * ((c >> 3) & 1), qq = ((c >> 2) & 1) + 2 * (c >> 4);
      bf16x8 qa[2][4];
      float wf[2][2][8];
#pragma unroll
      for (int rb = 0; rb < 2; ++rb) {
#pragma unroll
        for (int ks = 0; ks < 4; ++ks) qa[rb][ks] = *(const bf16x8*)(Pb + (size_t)(t0 + rb * 4 + qq) * 2304 + 1536 + hd * 64 + ks * 16 + h * 8);
#pragma unroll
        for (int q2 = 0; q2 < 2; ++q2) {
          const bf16x8 wv = *(const bf16x8*)(Pb + (size_t)(t0 + rb * 4 + h + 2 * q2) * 2304 + 2112);
#pragma unroll
          for (int j = 0; j < 8; ++j) wf[rb][q2][j] = (bfs(wv[j]) * 0.35355339059327373f) * 0.125f;
        }
      }
      const int nkb = (t0 + 7) / 32 + 1;
#pragma unroll 1
      for (int kb0 = 0; kb0 < nkb; kb0 += 16) {
        bf16x8 kf[4][4];
#pragma unroll
        for (int u = 0; u < 4; ++u) {
          const int kb = kb0 + wave + 4 * u; const int kbc = kb < 127 ? kb : 127;
          const u16* kp = Pb + (size_t)(kbc * 32 + c) * 2304 + 2048 + h * 8;
#pragma unroll
          for (int ks = 0; ks < 4; ++ks) kf[u][ks] = *(const bf16x8*)(kp + ks * 16);
        }
#pragma unroll
        for (int u = 0; u < 4; ++u) {
          const int key = (kb0 + wave + 4 * u) * 32 + c;
#pragma unroll
          for (int rb = 0; rb < 2; ++rb) {
            f32x16 acc = zero16();
#pragma unroll
            for (int ks = 0; ks < 4; ++ks) acc = MFMA32(qa[rb][ks], kf[u][ks], acc);
            float s0 = 0.f, s1 = 0.f;
#pragma unroll
            for (int i = 0; i < 8; ++i) {
              const int hh = (i & 3) + 4 * ((i >> 2) & 1);
              const float a0 = acc[i], a1 = acc[8 + i];
              s0 += wf[rb][0][hh] * (a0 > 0.f ? a0 : 0.f); s1 += wf[rb][1][hh] * (a1 > 0.f ? a1 : 0.f);
            }
            const int q0 = rb * 4 + h, q1 = rb * 4 + h + 2;
            if (key <= t0 + q0) sc[q0 * 4096 + key] = (u16)hkey(s0);
            if (key <= t0 + q1) sc[q1 * 4096 + key] = (u16)hkey(s1);
          }
        }
      }
    }
    __syncthreads();
#pragma unroll 1
    for (int qs = 0; qs < 2; ++qs) {
      const int tid2 = tidx(wv_); const int lane = tid2 & 63, wave = tid2 >> 6;
      const int qsel = wave + 4 * qs;
      const int t = t0 + qsel, n = t + 1;
      const u16* myS = sc + qsel * 4096;
      unsigned* myH = hist + wave * 256;
      unsigned prefix = 0; int need = 256;
#pragma unroll 1
      for (int pass = 0; pass < 2; ++pass) {
        const int shift = 8 - 8 * pass;
        *(uint4*)(myH + lane * 4) = make_uint4(0, 0, 0, 0);
        asm volatile("s_waitcnt lgkmcnt(0)" ::: "memory");
        for (int j8 = lane * 8; j8 < n; j8 += 512) {
          const bf16x8 kv = *(const bf16x8*)(myS + j8);
#pragma unroll
          for (int e = 0; e < 8; ++e) {
            const unsigned u = (unsigned)(u16)kv[e];
            const bool ok = (j8 + e < n) && ((pass == 0) ? true : ((u >> 8) == prefix));
            if (ok) atomicAdd(&myH[(u >> shift) & 255], 1u);
          }
        }
        asm volatile("s_waitcnt lgkmcnt(0)" ::: "memory");
        uint4 hv = *(const uint4*)(myH + lane * 4);
        int tot = (int)(hv.x + hv.y + hv.z + hv.w);
        int incl = tot;
#pragma unroll
        for (int off = 1; off < 64; off <<= 1) { int v = shdown(incl, off); if (lane + off < 64) incl += v; }
        int above = incl - tot;
        bool hit = (above < need) && (need <= incl);
        int bin = 0, nn = need;
        if (hit) {
          int a = above;
          if (need <= a + (int)hv.w) { bin = 3; nn = need - a; }
          else { a += hv.w; if (need <= a + (int)hv.z) { bin = 2; nn = need - a; }
            else { a += hv.z; if (need <= a + (int)hv.y) { bin = 1; nn = need - a; } else { a += hv.y; bin = 0; nn = need - a; } } }
          bin += lane * 4;
        }
        unsigned long long mk = __ballot(hit);
        int src = mk ? (__ffsll((long long)mk) - 1) : 0;
        bin = shidx(bin, src); nn = shidx(nn, src);
        prefix = (prefix << 8) | (unsigned)bin; need = nn;
      }
      u16* mySel = sel + wave * 256;
      int cnt = 0;
      if (n <= 256) {
        for (int j = lane; j < 256; j += 64) mySel[j] = (u16)((j < n) ? j : 0);
        cnt = n;
      } else {
        int eqseen = 0;
        const unsigned long long lt = (1ull << lane) - 1ull;
        for (int j0 = 0; j0 < n; j0 += 64) {
          const int j = j0 + lane; const bool v = j < n;
          unsigned u = v ? (unsigned)myS[j] : 0u;
          const bool gt = v && (u > prefix), eq = v && (u == prefix);
          unsigned long long be = __ballot(eq);
          const bool take = gt || (eq && (eqseen + __popcll(be & lt) < need));
          unsigned long long bt = __ballot(take);
          int pos = cnt + __popcll(bt & lt);
          if (take && pos < 256) mySel[pos] = (u16)j;
          cnt += __popcll(bt); eqseen += __popcll(be);
        }
        if (cnt > 256) cnt = 256;
      }
      asm volatile("s_waitcnt lgkmcnt(0)" ::: "memory");
      {
        u16* gsel = (u16*)(ws_ + WS_SEL) + ((size_t)b * SEQ + t) * 256;
        unsigned char* gselb = (unsigned char*)(ws_ + WS_SELB) + ((size_t)b * SEQ + t) * 256;
        for (int j = lane; j < 256; j += 64) {
          const int tk = (int)mySel[j];
          gsel[j] = (u16)tk;
          gselb[j] = (unsigned char)((j < cnt) ? t5_bucket(t - tk > 0 ? t - tk : 0) : 32);
        }
        if (lane == 0) ((int*)(ws_ + WS_CNT))[(size_t)b * SEQ + t] = cnt;
      }
      asm volatile("s_waitcnt lgkmcnt(0)" ::: "memory");
    }
    __syncthreads();
  }
}

DI void phase_mix_b2(int wv_, int vb_, int nvb_, char* ws_, const Ctx& p, char* smem) {
  const u16* P = (const u16*)(ws_ + WS_P);
  u16* Y = (u16*)(ws_ + WS_H);
  float* sbias = (float*)(smem + 65536);
  u16* selL = (u16*)(smem + 65536 + 2112);
  unsigned char* selbL = (unsigned char*)(smem + 65536 + 2112 + 2048);
  {
    const int tid = tidx(wv_);
    for (int i = tid; i < 512; i += 256) sbias[i] = p.rel_bias[(i >> 4) * 40 + 24 + (i & 15)] * 1.4426950408889634f;
    if (tid < 16) sbias[512 + tid] = -INFINITY;
  }
  __syncthreads();
  for (int ib = vb_; ib < 32768; ib += nvb_) {
    const int tid = tidx(wv_); const int lane = tid & 63, wave = tid >> 6, n16 = tid & 15, fq = (tid >> 4) & 3;
    const int b = ib & 7, r4 = ib >> 3, hkv = r4 >> 10, t = (r4 & 1023) * 4 + wave;
    const u16* Pb = P + (size_t)b * SEQ * 2304;
    u16* mySel = selL + wave * 256;
    unsigned char* mySelb = selbL + wave * 256;
    const size_t qrow = (size_t)b * SEQ + t;
    asm volatile("s_waitcnt lgkmcnt(0)" ::: "memory");
    *(uint2*)(mySel + lane * 4) = *(const uint2*)((const u16*)(ws_ + WS_SEL) + qrow * 256 + lane * 4);
    *(unsigned*)(mySelb + lane * 4) = *(const unsigned*)((const unsigned char*)(ws_ + WS_SELB) + qrow * 256 + lane * 4);
    asm volatile("s_waitcnt lgkmcnt(0)" ::: "memory");
    bf16x8 qf[2];
    {
      const u16* qp = Pb + (size_t)t * 2304 + (hkv * 4 + (n16 & 3)) * 64 + fq * 8;
      qf[0] = *(const bf16x8*)qp; qf[1] = *(const bf16x8*)(qp + 32);
      if (n16 >= 4) { qf[0] = zero8(); qf[1] = zero8(); }
    }
    f32x4 lg[16];
    char* Ks = smem + wave * 16384;
    bf16x8 vreg[16];
#define LOADKV(BASECOL, SH) { _Pragma("unroll") for (int rr = 0; rr < 16; ++rr) { \
      const unsigned vo_ = (unsigned)mySel[(SH) * 128 + rr * 8 + (lane >> 3)] * 4608u + (unsigned)(hkv * 128 + (lane & 7) * 16); \
      vreg[rr] = *(const bf16x8*)((const char*)(Pb + (BASECOL)) + (size_t)vo_); } }
#define LOADV(SH) LOADKV(1280, SH)
#define KWRITE() { _Pragma("unroll") for (int rr = 0; rr < 16; ++rr) { const int row_ = rr * 8 + (lane >> 3), piece_ = lane & 7; \
      *(bf16x8*)(Ks + row_ * 128 + ((piece_ ^ (row_ & 7)) * 16)) = vreg[rr]; } }
#define QKSTAGE(SH) { _Pragma("unroll") for (int kbl = 0; kbl < 8; ++kbl) { const int row_ = kbl * 16 + n16; \
      const bf16x8 k0_ = *(const bf16x8*)(Ks + row_ * 128 + ((fq ^ (row_ & 7)) * 16)); \
      const bf16x8 k1_ = *(const bf16x8*)(Ks + row_ * 128 + (((4 + fq) ^ (row_ & 7)) * 16)); \
      f32x4 a_ = {0.f, 0.f, 0.f, 0.f}; a_ = MFMA16(k0_, qf[0], a_); a_ = MFMA16(k1_, qf[1], a_); lg[(SH) * 8 + kbl] = a_; } }
    bf16x8 vreg2[16];
#define LOADKV2(BASECOL, SH) { _Pragma("unroll") for (int rr = 0; rr < 16; ++rr) { \
      const unsigned vo_ = (unsigned)mySel[(SH) * 128 + rr * 8 + (lane >> 3)] * 4608u + (unsigned)(hkv * 128 + (lane & 7) * 16); \
      vreg2[rr] = *(const bf16x8*)((const char*)(Pb + (BASECOL)) + (size_t)vo_); } }
#define KWRITE2() { _Pragma("unroll") for (int rr = 0; rr < 16; ++rr) { const int row_ = rr * 8 + (lane >> 3), piece_ = lane & 7; \
      *(bf16x8*)(Ks + row_ * 128 + ((piece_ ^ (row_ & 7)) * 16)) = vreg2[rr]; } }
    LOADKV(1024, 0)
    LOADKV2(1024, 1)
    asm volatile("s_waitcnt lgkmcnt(0)" ::: "memory");
    KWRITE()
    asm volatile("s_waitcnt lgkmcnt(0)" ::: "memory");
    QKSTAGE(0)
    asm volatile("s_waitcnt lgkmcnt(0)" ::: "memory");
    KWRITE2()
    LOADV(0)
    asm volatile("s_waitcnt lgkmcnt(0)" ::: "memory");
    QKSTAGE(1)
    asm volatile("s_waitcnt lgkmcnt(0)" ::: "memory");
    LOADKV2(1280, 1)
#undef LOADKV2
#undef KWRITE2
#undef KWRITE
#undef QKSTAGE
    float mx = -INFINITY;
#pragma unroll
    for (int kb = 0; kb < 16; ++kb)
#pragma unroll
      for (int i = 0; i < 4; ++i) {
        const unsigned bk4 = *(const unsigned*)(mySelb + kb * 16 + fq * 4);
        const int bk = (bk4 >> (8 * i)) & 255;
        const float bv = sbias[bk * 16 + hkv * 4 + (n16 & 3)];
        const float v = lg[kb][i] + bv;
        lg[kb][i] = v; mx = fmaxf(mx, v);
      }
    mx = fmaxf(mx, shx(mx, 16)); mx = fmaxf(mx, shx(mx, 32));
    float sum = 0.f;
#pragma unroll
    for (int kb = 0; kb < 16; ++kb)
#pragma unroll
      for (int i = 0; i < 4; ++i) { float pv = __builtin_amdgcn_exp2f(lg[kb][i] - mx); lg[kb][i] = pv; sum += pv; }
    sum += shx(sum, 16); sum += shx(sum, 32);
    bf16x8 pall[8];
#pragma unroll
    for (int q = 0; q < 8; ++q)
#pragma unroll
      for (int j = 0; j < 4; ++j) { pall[q][j] = (short)f2bf(lg[2 * q][j]); pall[q][4 + j] = (short)f2bf(lg[2 * q + 1][j]); }
    char* Vs = smem + wave * 16384;
    float invs[4];
#pragma unroll
    for (int i = 0; i < 4; ++i) invs[i] = 1.0f / shidx(sum, i);
    f32x4 oacc[4];
#pragma unroll
    for (int cb = 0; cb < 4; ++cb) oacc[cb] = (f32x4){0.f, 0.f, 0.f, 0.f};
#pragma unroll
    for (int sh = 0; sh < 2; ++sh) {
      asm volatile("s_waitcnt lgkmcnt(0)" ::: "memory");
#pragma unroll
      for (int rr = 0; rr < 16; ++rr) {
        const int row = rr * 8 + (lane >> 3), piece = lane & 7;
        *(bf16x8*)(Vs + row * 128 + (((piece >> 1) ^ ((row >> 1) & 3)) * 32) + (piece & 1) * 16) = (sh == 0) ? vreg[rr] : vreg2[rr];
      }
      asm volatile("s_waitcnt lgkmcnt(0)" ::: "memory");
#pragma unroll
      for (int ks = 0; ks < 4; ++ks) {
        const bf16x8 pa = pall[sh * 4 + ks];
        const int rlo = ks * 32 + fq * 4 + (n16 >> 2);
        const int sw = (rlo >> 1) & 3;
#pragma unroll
        for (int cb = 0; cb < 4; ++cb) {
          const int off = ((cb ^ sw) * 32) + (n16 & 3) * 8;
          s16x4 lo = __builtin_amdgcn_ds_read_tr16_b64_v4i16((__attribute__((address_space(3))) s16x4*)(Vs + rlo * 128 + off));
          s16x4 hi = __builtin_amdgcn_ds_read_tr16_b64_v4i16((__attribute__((address_space(3))) s16x4*)(Vs + (16 + rlo) * 128 + off));
          bf16x8 vb = __builtin_shufflevector(lo, hi, 0, 1, 2, 3, 4, 5, 6, 7);
          oacc[cb] = MFMA16(pa, vb, oacc[cb]);
        }
      }
    }
#undef LOADV
#undef LOADKV
    if (fq == 0) {
      u16* yp = Y + qrow * 1024 + hkv * 256;
#pragma unroll
      for (int i = 0; i < 4; ++i)
#pragma unroll
        for (int cb = 0; cb < 4; ++cb) yp[i * 64 + cb * 16 + n16] = f2bf(oacc[cb][i] * invs[i]);
    }
  }
  __syncthreads();
}

DI float f4c(const float4& v, int k) { return k == 0 ? v.x : (k == 1 ? v.y : (k == 2 ? v.z : v.w)); }
template <int I> struct SolveRows {
  static DI void run(float (&U)[64], const u16* rsrc, const float* rsc, const float* sAm, const float4 (&cur)[16], float rhs) {
    float4 nxt[16]; float rhsn = 0.f;
    if constexpr (I + 1 < 64) {
#pragma unroll
      for (int q = 0; q < (I + 1 + 3) / 4; ++q) nxt[q] = *(const float4*)(sAm + (I + 1) * 68 + q * 4);
      rhsn = bf2f(rsrc[(I + 1) * 136]) * rsc[I + 1];
    }
    __builtin_amdgcn_sched_barrier(0);
    float a = rhs;
#pragma unroll
    for (int j = 0; j < I; ++j) a -= f4c(cur[j >> 2], j & 3) * U[j];
    U[I] = a;
    if constexpr (I + 1 < 64) SolveRows<I + 1>::run(U, rsrc, rsc, sAm, nxt, rhsn);
  }
};
DI void phase_prep_c(int wv_, int vb_, int nvb_, char* ws_, const Ctx& p, char* smem, int half) {
  float* sAm = (float*)smem;
  float* sbeta = sAm + 64 * 68;
  float* sgc = sbeta + 64;
  float* sbg = sgc + 64;
  float* scw = sbg + 64;
  u16* sq = (u16*)(scw + 1536);
  u16* sk = sq + 64 * 136;
  u16* sv = sk + 64 * 136;
  const u16* PQ = (const u16*)(ws_ + WS_CQKV);
  const float* side = (const float*)(ws_ + WS_SIDE);
  u16* halo = (u16*)(ws_ + WS_HALO);
  u16* CW = (u16*)(ws_ + WS_CW); u16* CU = (u16*)(ws_ + WS_CU); u16* CQ = (u16*)(ws_ + WS_CQ);
  u16* CKT = (u16*)(ws_ + WS_CKT); u16* CQK = (u16*)(ws_ + WS_CQK);
  float* GL = (float*)(ws_ + WS_GL);
  const int tid = tidx(wv_), lane = tid & 63, wave = tid >> 6, c = lane & 31, h = lane >> 5;
  for (int k_ = 0; k_ < (2048 + nvb_ - 1) / nvb_; ++k_) {
    const int uix = (vb_ + k_ * nvb_ < 2048) ? vb_ + k_ * nvb_ : 2047;
    const int nc = uix & 31, hd = (uix >> 5) & 7, b = uix >> 8;
    const int n = half * 32 + nc;
    {
      const int tid = tidx(wv_);
      for (int i = tid; i < 1536; i += 256) scw[i] = p.c_conv_w[(i / 384) * 3072 + ((i % 384) >> 7) * 1024 + hd * 128 + (i & 127)];
      __syncthreads();
      const int i = tid >> 2, p4 = tid & 3;
#pragma unroll 1
      for (int which = 0; which < 3; ++which) {
        const int colbase = which * 1024 + hd * 128 + p4 * 32;
        bf16x8 xv[4][4];
#pragma unroll
        for (int j = 0; j < 4; ++j) {
          const int ri = i - 3 + j;
          const u16* src = PQ + ((size_t)b * 2048 + nc * 64 + (ri >= 0 || nc > 0 ? ri : 0)) * 3072 + colbase;
          const bool zr = (ri < 0 && nc == 0 && half == 0);
          if (ri < 0 && nc == 0 && half == 1) src = halo + ((size_t)b * 3 + (3 + ri)) * 3072 + colbase;
#pragma unroll
          for (int q = 0; q < 4; ++q) { bf16x8 t_ = *(const bf16x8*)(src + q * 8);
#pragma unroll
            for (int e = 0; e < 8; ++e) t_[e] = zr ? (short)0 : t_[e];
            xv[j][q] = t_; }
        }
        if (half == 0 && nc == 31 && i >= 61) {
#pragma unroll
          for (int q = 0; q < 4; ++q) *(bf16x8*)(halo + ((size_t)b * 3 + (i - 61)) * 3072 + colbase + q * 8) = xv[3][q];
        }
        float acc[32];
#pragma unroll
        for (int e = 0; e < 32; ++e) acc[e] = 0.f;
#pragma unroll
        for (int j = 0; j < 4; ++j) {
          const float* wp = scw + j * 384 + which * 128 + p4 * 32;
#pragma unroll
          for (int q = 0; q < 4; ++q) {
            const float4 wa = *(const float4*)(wp + q * 8), wb = *(const float4*)(wp + q * 8 + 4);
            acc[q * 8 + 0] += wa.x * bfs(xv[j][q][0]); acc[q * 8 + 1] += wa.y * bfs(xv[j][q][1]); acc[q * 8 + 2] += wa.z * bfs(xv[j][q][2]); acc[q * 8 + 3] += wa.w * bfs(xv[j][q][3]);
            acc[q * 8 + 4] += wb.x * bfs(xv[j][q][4]); acc[q * 8 + 5] += wb.y * bfs(xv[j][q][5]); acc[q * 8 + 6] += wb.z * bfs(xv[j][q][6]); acc[q * 8 + 7] += wb.w * bfs(xv[j][q][7]);
          }
        }
        float ss = 0.f;
#pragma unroll
        for (int e = 0; e < 32; ++e) { float a = acc[e]; a = a * __builtin_amdgcn_rcpf(1.0f + __expf(-a)); acc[e] = a; ss += a * a; }
        float scale = 1.f;
        if (which < 2) {
          ss += shx(ss, 1); ss += shx(ss, 2);
          scale = rsqrtf(ss + 1e-6f);
          if (which == 0) scale *= 0.08838834764831845f;
        }
        u16* dst = (which == 0 ? sq : (which == 1 ? sk : sv)) + i * 136 + p4 * 32;
#pragma unroll
        for (int q = 0; q < 4; ++q) {
          bf16x8 o;
#pragma unroll
          for (int e = 0; e < 8; ++e) o[e] = (short)f2bf(acc[q * 8 + e] * scale);
          *(bf16x8*)(dst + q * 8) = o;
        }
      }
    }
    if ((tidx(wv_) >> 6) == 0) {
      const int lane = tidx(wv_) & 63;
      const size_t tok = (size_t)b * SEQ + n * 64 + lane;
      float bb = side[tok * 16 + hd], aa = side[tok * 16 + 8 + hd];
      float beta = 1.0f / (1.0f + __expf(-bb));
      float xx = aa + p.c_dt_bias[hd];
      float sp = fmaxf(xx, 0.f) + log1pf(__expf(-fabsf(xx)));
      float gcv = -__expf(p.c_a_log[hd]) * sp;
#pragma unroll
      for (int off = 1; off < 64; off <<= 1) { float v = shup(gcv, off); if (lane >= off) gcv += v; }
      sbeta[lane] = beta; sgc[lane] = gcv; sbg[lane] = beta * __expf(gcv);
      if (lane == 63) GL[uix] = __expf(gcv);
    }
    __syncthreads();
    {
      const int tid = tidx(wv_); const int wave = tid >> 6, c = tid & 31, h = (tid >> 5) & 1;
      const int bi = wave >> 1, bj = wave & 1;
      f32x16 akk = zero16(), aqk = zero16();
#pragma unroll
      for (int ks = 0; ks < 8; ++ks) {
        bf16x8 ka = *(const bf16x8*)(sk + (bi * 32 + c) * 136 + ks * 16 + h * 8);
        bf16x8 qa = *(const bf16x8*)(sq + (bi * 32 + c) * 136 + ks * 16 + h * 8);
        bf16x8 kb = *(const bf16x8*)(sk + (bj * 32 + c) * 136 + ks * 16 + h * 8);
        akk = MFMA32(ka, kb, akk); aqk = MFMA32(qa, kb, aqk);
      }
      const int jj = bj * 32 + c;
      const float gj = sgc[jj];
      u16* qko = CQK + (size_t)uix * 4096;
#pragma unroll
      for (int i = 0; i < 16; ++i) {
        const int ii = bi * 32 + crow(i, h);
        const float dg = sgc[ii] - gj;
        const float dec = (jj <= ii) ? __expf(dg) : 0.f;
        sAm[ii * 68 + jj] = (jj < ii) ? sbeta[ii] * akk[i] * dec : 0.f;
        qko[ii * 64 + kpos(jj)] = f2bf(aqk[i] * dec);
      }
    }
    __syncthreads();
    {
      const int tid = tidx(wv_); const int wave = tid >> 6, lane = tid & 63;
      const int cw = wave * 64 + lane;
      const bool isu = wave < 2;
      const u16* rsrc = isu ? (sv + cw) : (sk + (cw - 128));
      const float* rsc = isu ? sbeta : sbg;
      float U[64];
      { float4 c0[16]; SolveRows<0>::run(U, rsrc, rsc, sAm, c0, bf2f(rsrc[0]) * rsc[0]); }
      if (isu) {
        u16* dst = CU + ((size_t)uix * 128 + cw) * 64;
#pragma unroll
        for (int g8 = 0; g8 < 8; ++g8) {
          bf16x8 o;
#pragma unroll
          for (int e = 0; e < 8; ++e) {
            const int pos = g8 * 8 + e;
            const int tb = pos >> 5, hh = (pos >> 4) & 1, ii = pos & 15;
            o[e] = (short)f2bf(U[tb * 32 + crow(ii, hh)]);
          }
          *(bf16x8*)(dst + g8 * 8) = o;
        }
      } else {
        u16* dst = CW + (size_t)uix * 8192 + kpos(cw - 128);
#pragma unroll
        for (int i = 0; i < 64; ++i) dst[i * 128] = f2bf(U[i]);
      }
    }
    {
      const int tid = tidx(wv_);
      const int i = tid >> 2, p4 = tid & 3;
      const float eg = __expf(sgc[i]);
      u16* dst = CQ + (size_t)uix * 8192 + i * 128 + p4 * 32;
      const u16* srow = sq + i * 136 + p4 * 32;
#pragma unroll
      for (int g8 = 0; g8 < 4; ++g8) {
        bf16x8 o;
#pragma unroll
        for (int e = 0; e < 8; ++e) {
          const int pos = g8 * 8 + e;
          const int s = pos >> 4, hh = (pos >> 3) & 1, j = pos & 7;
          const int d = 16 * s + 8 * (j >> 2) + 4 * hh + (j & 3);
          o[e] = (short)f2bf(bf2f(srow[d]) * eg);
        }
        *(bf16x8*)(dst + g8 * 8) = o;
      }
      const int d = tid & 127, th = tid >> 7;
      const float gl = sgc[63];
      u16* dk = CKT + ((size_t)uix * 128 + d) * 64 + th * 32;
#pragma unroll
      for (int g8 = 0; g8 < 4; ++g8) {
        bf16x8 o;
#pragma unroll
        for (int e = 0; e < 8; ++e) {
          const int pos = g8 * 8 + e;
          const int s = pos >> 4, hh = (pos >> 3) & 1, j = pos & 7;
          const int tt = th * 32 + 16 * s + 8 * (j >> 2) + 4 * hh + (j & 3);
          o[e] = (short)f2bf(bf2f(sk[tt * 136 + d]) * __expf(gl - sgc[tt]));
        }
        *(bf16x8*)(dk + g8 * 8) = o;
      }
    }
    __syncthreads();
  }
}

DI void phase_scan_c(int wv_, int vb_, int nvb_, char* ws_, const Ctx& p, char* smem, int half) {
  const u16* CW = (const u16*)(ws_ + WS_CW); const u16* CU = (const u16*)(ws_ + WS_CU); const u16* CQ = (const u16*)(ws_ + WS_CQ);
  const u16* CKT = (const u16*)(ws_ + WS_CKT); const u16* CQK = (const u16*)(ws_ + WS_CQK);
  const float* GL = (const float*)(ws_ + WS_GL);
  float* ST = (float*)(ws_ + WS_STATE);
  u16* O = (u16*)(ws_ + WS_H);
  u16* sW = (u16*)smem;
  u16* sQ = sW + 64 * 136;
  u16* sKT = sQ + 64 * 136;
  u16* sQK = sKT + 128 * 72;
  const int tid = tidx(wv_), lane = tid & 63, wave = tid >> 6, c = lane & 31, h = lane >> 5;
  if ((vb_ >> 1) < 64 && (vb_ & 1)) { for (int q_ = 0; q_ < 66; ++q_) __syncthreads(); }
  if ((vb_ >> 1) < 64 && !(vb_ & 1)) {
    const int blk = vb_ >> 1;
    const int b = blk >> 3, hd = blk & 7, dv0 = wave * 32;
    f32x16 S[4];
    float* stp = ST + ((size_t)(blk * 4 + wave) * 64) * 64 + lane;
    if (half == 0) {
#pragma unroll
      for (int mb = 0; mb < 4; ++mb) S[mb] = zero16();
    } else {
#pragma unroll
      for (int mb = 0; mb < 4; ++mb)
#pragma unroll
        for (int i = 0; i < 16; ++i) S[mb][i] = stp[(mb * 16 + i) * 64];
    }
    bf16x8 gw[4], gq[4], gk[4], gqk[2];
#define SLOAD(UIX) { const size_t u_ = (UIX); \
      _Pragma("unroll") for (int i = 0; i < 4; ++i) { gw[i] = *(const bf16x8*)(CW + u_ * 8192 + (size_t)(tid + 256 * i) * 8); gq[i] = *(const bf16x8*)(CQ + u_ * 8192 + (size_t)(tid + 256 * i) * 8); \
        gk[i] = *(const bf16x8*)(CKT + u_ * 8192 + (size_t)(tid + 256 * i) * 8); } \
      _Pragma("unroll") for (int i = 0; i < 2; ++i) gqk[i] = *(const bf16x8*)(CQK + u_ * 4096 + (size_t)(tid + 256 * i) * 8); }
#define SWRITE() { _Pragma("unroll") for (int i = 0; i < 4; ++i) { const int id_ = tid + 256 * i; \
        *(bf16x8*)(sW + (id_ >> 4) * 136 + (id_ & 15) * 8) = gw[i]; *(bf16x8*)(sQ + (id_ >> 4) * 136 + (id_ & 15) * 8) = gq[i]; \
        *(bf16x8*)(sKT + (id_ >> 3) * 72 + (id_ & 7) * 8) = gk[i]; } \
      _Pragma("unroll") for (int i = 0; i < 2; ++i) { const int id_ = tid + 256 * i; *(bf16x8*)(sQK + (id_ >> 3) * 72 + (id_ & 7) * 8) = gqk[i]; } }
    SLOAD((size_t)blk * 32)
    __syncthreads();
    SWRITE()
    __syncthreads();
#pragma unroll 1
    for (int nc = 0; nc < 32; ++nc) {
      const size_t uix = (size_t)blk * 32 + nc;
      const float egl = GL[uix];
      bf16x8 ucur[4];
#pragma unroll
      for (int tb = 0; tb < 2; ++tb) { ucur[2 * tb] = *(const bf16x8*)(CU + (uix * 128 + dv0 + c) * 64 + h * 16 + tb * 32); ucur[2 * tb + 1] = *(const bf16x8*)(CU + (uix * 128 + dv0 + c) * 64 + h * 16 + tb * 32 + 8); }
      const u16* Wp = sW + c * 136 + h * 8;
      const u16* Qp = sQ + c * 136 + h * 8;
      const u16* KTp = sKT + c * 72 + h * 8;
      const u16* QKp = sQK + c * 72 + h * 8;
      f32x16 X[2], Oa[2];
      X[0] = zero16(); X[1] = zero16(); Oa[0] = zero16(); Oa[1] = zero16();
#pragma unroll
      for (int mb = 0; mb < 4; ++mb) {
#pragma unroll
        for (int s = 0; s < 2; ++s) {
          const bf16x8 sb = pack8(S[mb], s);
#pragma unroll
          for (int tb = 0; tb < 2; ++tb) {
            bf16x8 a = *(const bf16x8*)(Wp + tb * 32 * 136 + mb * 32 + s * 16);
            bf16x8 a2 = *(const bf16x8*)(Qp + tb * 32 * 136 + mb * 32 + s * 16);
            X[tb] = MFMA32(a, sb, X[tb]);
            Oa[tb] = MFMA32(a2, sb, Oa[tb]);
          }
        }
      }
      bf16x8 vb[2][2];
#pragma unroll
      for (int tb = 0; tb < 2; ++tb) {
#pragma unroll
        for (int i = 0; i < 8; ++i) { X[tb][i] = bfs(ucur[2 * tb][i]) - X[tb][i]; X[tb][8 + i] = bfs(ucur[2 * tb + 1][i]) - X[tb][8 + i]; }
        vb[tb][0] = pack8(X[tb], 0); vb[tb][1] = pack8(X[tb], 1);
      }
      { const int ncn = nc < 31 ? nc + 1 : 31; SLOAD((size_t)blk * 32 + ncn) }
#pragma unroll
      for (int tb = 0; tb < 2; ++tb)
#pragma unroll
        for (int tb2 = 0; tb2 < 2; ++tb2)
#pragma unroll
          for (int s = 0; s < 2; ++s) {
            bf16x8 a = *(const bf16x8*)(QKp + tb * 32 * 72 + tb2 * 32 + s * 16);
            Oa[tb] = MFMA32(a, vb[tb2][s], Oa[tb]);
          }
#pragma unroll
      for (int mb = 0; mb < 4; ++mb) {
#pragma unroll
        for (int i = 0; i < 16; ++i) S[mb][i] *= egl;
#pragma unroll
        for (int tb = 0; tb < 2; ++tb)
#pragma unroll
          for (int s = 0; s < 2; ++s) {
            bf16x8 a = *(const bf16x8*)(KTp + mb * 32 * 72 + tb * 32 + s * 16);
            S[mb] = MFMA32(a, vb[tb][s], S[mb]);
          }
      }
      u16* op = O + ((size_t)b * SEQ + (size_t)(half * 32 + nc) * 64) * 1024 + hd * 128 + dv0 + c;
#pragma unroll
      for (int tb = 0; tb < 2; ++tb)
#pragma unroll
        for (int i = 0; i < 16; ++i) op[(size_t)(tb * 32 + crow(i, h)) * 1024] = f2bf(Oa[tb][i]);
      __syncthreads();
      SWRITE()
      __syncthreads();
    }
#undef SLOAD
#undef SWRITE
    if (half == 0) {
#pragma unroll
      for (int mb = 0; mb < 4; ++mb)
#pragma unroll
        for (int i = 0; i < 16; ++i) stp[(mb * 16 + i) * 64] = S[mb][i];
    }
  }
}

DI void phase_outnorm_c(int wv_, int vb_, int nvb_, char* ws_, const Ctx& p) {
  u16* O = (u16*)(ws_ + WS_H); const u16* G = (const u16*)(ws_ + WS_CG);
  const int tid = tidx(wv_); const int e = tid & 15;
  float og[8];
#pragma unroll
  for (int j = 0; j < 8; ++j) og[j] = p.c_o_gain[e * 8 + j];
  const size_t stride = (size_t)nvb_ * 256, total = (size_t)NTOK * 8 * 16;
  for (size_t idx0 = (size_t)vb_ * 256 + tid; idx0 < total; idx0 += 4 * stride) {
    bf16x8 ov[4], gv[4]; bool ok[4];
#pragma unroll
    for (int q = 0; q < 4; ++q) { const size_t idx = idx0 + q * stride; ok[q] = idx < total; const size_t rowh = (ok[q] ? idx : idx0) >> 4;
      ov[q] = *(const bf16x8*)(O + rowh * 128 + e * 8); gv[q] = *(const bf16x8*)(G + rowh * 128 + e * 8); }
#pragma unroll
    for (int q = 0; q < 4; ++q) {
      float f[8]; float ss = 0.f;
#pragma unroll
      for (int j = 0; j < 8; ++j) { f[j] = bfs(ov[q][j]); ss += f[j] * f[j]; }
      ss += shx(ss, 1); ss += shx(ss, 2); ss += shx(ss, 4); ss += shx(ss, 8);
      const float rn = rsqrtf(ss * (1.0f / 128.0f) + 1e-6f);
      bf16x8 o;
#pragma unroll
      for (int j = 0; j < 8; ++j) { float gt = bfs(gv[q][j]); float sl = gt * __builtin_amdgcn_rcpf(1.0f + __expf(-gt)); o[j] = (short)f2bf(f[j] * rn * og[j] * sl); }
      if (ok[q]) *(bf16x8*)(O + ((idx0 + q * stride) >> 4) * 128 + e * 8) = o;
    }
  }
}

#define XB_TMO      128
#define XB_XCNT(j)  (256  + 64 * (j))
#define XB_XSUB(j)  (1280 + 64 * (j))
#define XB_XGEN(j)  (2304 + 64 * (j))
#define XB_TOP      3328
#define XB_TOPGEN   3392
#define XCD_BAR_WORDS 3456
#define XB_SPIN_CAP (1u << 23)
DI unsigned xb_ld(unsigned* p)              { return __hip_atomic_load(p, __ATOMIC_RELAXED, __HIP_MEMORY_SCOPE_AGENT); }
DI unsigned xb_add(unsigned* p, unsigned v) { return __hip_atomic_fetch_add(p, v, __ATOMIC_RELAXED, __HIP_MEMORY_SCOPE_AGENT); }
DI unsigned xb_xcc_id() { return (unsigned)__builtin_amdgcn_s_getreg((3 << 11) | 20) & 0xFu; }
#define XB_SPIN(cond, bar) do { unsigned _sp = 0; while (cond) { __builtin_amdgcn_s_sleep(1); \
    if ((++_sp & 255u) == 0u) { if (xb_ld(&(bar)[XB_TMO])) break; if (_sp > XB_SPIN_CAP) { atomicAdd(&(bar)[XB_TMO], 1u); break; } } } } while (0)
struct XcdBarrier { unsigned* bar; unsigned x; volatile PG8_LAS unsigned* st; };
DI void xcd_barrier_complete(unsigned* bar, unsigned x, unsigned& nloc, unsigned& nx) {
    const unsigned G = gridDim.x;
    unsigned sum, cnt, mine, sp = 0u;
    for (;;) {
        sum = 0u; cnt = 0u; mine = 0u;
#pragma unroll
        for (unsigned j = 0; j < 16; ++j) { const unsigned c = xb_ld(&bar[XB_XCNT(j)]); sum += c; cnt += (c > 0u) ? 1u : 0u; mine = (j == x) ? c : mine; }
        if (sum == G) break;
        __builtin_amdgcn_s_sleep(1);
        if ((++sp & 255u) == 0u) { if (xb_ld(&bar[XB_TMO])) break; if (sp > XB_SPIN_CAP) { atomicAdd(&bar[XB_TMO], 1u); break; } }
    }
    nloc = mine > 0u ? mine : 1u; nx = cnt > 0u ? cnt : 1u;
}
DI void xcd_barrier(char* ws_base, char* lds_base, bool leader_thread) {
    asm volatile("s_waitcnt vmcnt(0)" ::: "memory");
    __syncthreads();
    if (leader_thread) {
        XcdBarrier b; b.bar = (unsigned*)(ws_base + WS_BAR); b.x = xb_xcc_id(); b.st = (volatile PG8_LAS unsigned*)(lds_base + 2 * HALF_LDS);
        unsigned* bar = b.bar;
        __builtin_amdgcn_s_waitcnt(0);
        unsigned nloc = b.st[0], nx = b.st[1];
        if (nloc == 0u) { xcd_barrier_complete(bar, b.x, nloc, nx); b.st[0] = nloc; b.st[1] = nx; }
        const unsigned old = xb_add(&bar[XB_XSUB(b.x)], 1u);
        const unsigned gen = old / nloc;
        if (old + 1u == (gen + 1u) * nloc) {
            __builtin_amdgcn_fence(__ATOMIC_RELEASE, "agent");
            asm volatile("s_waitcnt vmcnt(0)" ::: "memory");
            const unsigned og = xb_add(&bar[XB_TOP], 1u);
            const unsigned tg = og / nx;
            if (og + 1u == (tg + 1u) * nx) xb_add(&bar[XB_TOPGEN], 1u);
            else XB_SPIN(xb_ld(&bar[XB_TOPGEN]) == tg, bar);
            __builtin_amdgcn_fence(__ATOMIC_ACQUIRE, "agent");
            xb_add(&bar[XB_XGEN(b.x)], 1u);
            asm volatile("s_waitcnt vmcnt(0)" ::: "memory");
        } else {
            XB_SPIN(xb_ld(&bar[XB_XGEN(b.x)]) == gen, bar);
            __builtin_amdgcn_fence(__ATOMIC_ACQUIRE, "agent");
            asm volatile("s_waitcnt vmcnt(0)" ::: "memory");
        }
    }
    __syncthreads();
}

template <class Epi>
DI void run_gemm(int wv8_, const u16* A, const u16* Bt, int N, int K, int half, const Epi& E, int G_ = -1, int c_ = -1) {
  extern __shared__ __attribute__((aligned(16))) char smem0[];
  pg8::Gemm g; g.A = A; g.Bt = Bt; g.M = (half < 0) ? NTOK : NTOK / 2; g.N = N; g.K = K; g.half = half;
  pg8::StaticOrder S; S.init(g.M, g.N, G_ > 0 ? G_ : (int)gridDim.x, G_ > 0 ? c_ : (int)blockIdx.x);
  pg8::gemm_phase<Epi, pg8::StaticOrder>((PG8_LAS unsigned char*)smem0, g, S, E, tidx(wv8_));
  __syncthreads();
}

__global__ void __launch_bounds__(512, 2) mega(Params pp) {
  extern __shared__ __attribute__((aligned(16))) char smem0[];
  cg::grid_group grid = cg::this_grid();
  const int wv8_ = __builtin_amdgcn_readfirstlane((int)threadIdx.x >> 6);
  const int hb_ = wv8_ >> 2, wv_ = wv8_ & 3;
  const int vb_ = (int)blockIdx.x * 2 + hb_, nvb_ = (int)gridDim.x * 2;
  {
    volatile PG8_LAS unsigned* st = (volatile PG8_LAS unsigned*)(smem0 + 2 * HALF_LDS);
    const bool lead0 = tidx(wv8_) == 0;
    if (lead0) { st[0] = 0u; st[1] = 0u; (void)xb_add(&((unsigned*)(pp.c.ws + WS_BAR))[XB_XCNT(xb_xcc_id())], 1u); }
    __syncthreads();
  }
  if (pp.ph1 < 0) grid.sync();
#pragma unroll 1
  for (int ph = pp.ph0; ph < pp.ph1; ++ph) {
    const Ctx& p = pp.c;
    size_t wsoff_ = 0; asm volatile("" : "+s"(wsoff_));
    char* ws_ = pp.c.ws + wsoff_;
    unsigned smoff_ = 0; asm volatile("" : "+v"(smoff_));
    char* smem = smem0 + hb_ * HALF_LDS + smoff_;
    const u16* WT = (const u16*)(ws_ + WS_WT);
    u16* H = (u16*)(ws_ + WS_H);
    u16* Pm = (u16*)(ws_ + WS_P);
    const int code = pp.ops[ph];
    const int op = code & 15, l = (code >> 4) & 3, half = (code >> 6) & 1;
    const int kind = l % 3, j = l / 3;
    const float* xcur = (code >> 7) ? p.x : p.out;
    switch (op) {
      case OP_CONVERT: phase_convert(wv_, vb_, nvb_, ws_, p, smem); break;
      case OP_NORM_MIX: phase_norm(wv_, vb_, nvb_, xcur, p.norm_mix + l * DM, H); break;
      case OP_GEMM_IN:
        if (kind == 0) { pg8::EpiB16HN E; E.O = Pm; E.ldc = 4608; E.ncols_norm = 3072; E.nq_cols = 1536; E.gq = p.a_q_gain + j * 64; E.gk = p.a_k_gain + j * 64; E.T = (PG8_LAS float*)(smem0 + 131072);
          run_gemm(wv8_, H, WT + (size_t)j * 4718592u, 4608, 1024, -1, E); }
        else if (kind == 1) { pg8::EpiB16HN E; E.O = Pm; E.ldc = 2304; E.ncols_norm = 1280; E.nq_cols = 1024; E.gq = p.b_q_gain; E.gk = p.b_k_gain; E.T = (PG8_LAS float*)(smem0 + 131072);
          run_gemm(wv8_, H, WT + wOff(4), 2304, 1024, -1, E); }
        else { pg8::EpiCIn E; E.Q = (u16*)(ws_ + WS_CQKV); E.G = (u16*)(ws_ + WS_CG); E.S = (float*)(ws_ + WS_SIDE); E.half = half;
          run_gemm(wv8_, H, WT + wOff(6), 4352, 1024, half, E); }
        break;
      case OP_HEADNORM:
        if (kind == 0) phase_headnorm(wv_, vb_, nvb_, Pm, 4608, 48, 24, p.a_q_gain + j * 64, p.a_k_gain + j * 64);
        else phase_headnorm(wv_, vb_, nvb_, Pm, 2304, 20, 16, p.b_q_gain, p.b_k_gain);
        break;
      case OP_ATTN_A: phase_attn_a(wv_, vb_, nvb_, ws_, p, smem); break;
      case OP_COMBINE_A: phase_combine_a(wv_, vb_, nvb_, ws_, p); break;
      case OP_GEMM_OUT:
      case OP_GEMM_W2: {
        pg8::EpiResid E; E.C = p.out; E.X = xcur;
        const u16* Ag = H; int Kg = 1024; unsigned wo = wOff(7);
        if (op == OP_GEMM_W2) { Ag = Pm; Kg = 4096; wo = wOff(12) + (unsigned)l * 4194304u; }
        else if (kind == 0) { Kg = 512; wo = wOff(2) + (unsigned)j * 524288u; }
        else if (kind == 1) { wo = wOff(5); }
        run_gemm(wv8_, Ag, WT + wo, 1024, Kg, -1, E);
        break; }
      case OP_MIX_B: if (half == 0) phase_mix_b(wv_, vb_, nvb_, ws_, p, smem); else phase_mix_b2(wv_, vb_, nvb_, ws_, p, smem); break;
      case OP_PREP_C: phase_prep_c(wv_, vb_, nvb_, ws_, p, smem, half); break;
      case OP_SCAN_C: phase_scan_c(wv_, vb_, nvb_, ws_, p, smem, half); break;
      case OP_SCAN_GEMM:
        if ((int)blockIdx.x < 64) phase_scan_c(wv_, vb_, nvb_, ws_, p, smem, 0);
        else { pg8::EpiCIn E; E.Q = (u16*)(ws_ + WS_CQKV); E.G = (u16*)(ws_ + WS_CG); E.S = (float*)(ws_ + WS_SIDE); E.half = 1;
          run_gemm(wv8_, H, WT + wOff(6), 4352, 1024, 1, E, (int)gridDim.x - 64, (int)blockIdx.x - 64); }
        break;
      case OP_OUTNORM_C: phase_outnorm_c(wv_, vb_, nvb_, ws_, p); break;
      case OP_NORM_MLP: phase_norm(wv_, vb_, nvb_, xcur, p.norm_mlp + l * DM, H); break;
      case OP_GEMM_W1: { pg8::EpiB16<1> E; E.O = Pm; E.ldc = 4096; run_gemm(wv8_, H, WT + wOff(8) + (size_t)l * 4194304u, 4096, 1024, -1, E); break; }
      default: break;
    }
    const bool noseam = (op == OP_CONVERT) && half;
    if (ph + 1 < pp.ph1 && !noseam) xcd_barrier(ws_, smem0, tidx(wv8_) == 0);
  }
}

#ifndef MIXMASK
#define MIXMASK 15
#endif
#ifndef MULTI_LAUNCH
#define MULTI_LAUNCH 0
#endif
#ifndef REP_W1
#define REP_W1 1
#endif
#ifndef REP_MIXB
#define REP_MIXB 1
#endif
#ifndef REP_MIXB2
#define REP_MIXB2 1
#endif
#ifndef REP_C
#define REP_C 1
#endif
#ifndef REP_SCAN
#define REP_SCAN 1
#endif
#ifndef REP_ATTN
#define REP_ATTN 1
#endif
#ifndef REP_NORM
#define REP_NORM 1
#endif

extern "C" void kernel_launch(void* const* d_in, const int* in_sizes, int n_in, void* d_out, int out_size, void* d_ws, size_t ws_size, hipStream_t stream) {
  static int grid_blocks = 0;
  if (grid_blocks == 0) {
    if (n_in != 20 || ws_size < WS_END) { fprintf(stderr, "kernel_launch: bad n_in %d or ws %zu\n", n_in, ws_size); grid_blocks = -1; return; }
    int dev = 0, cus = 0, per_cu = 0;
    hipGetDevice(&dev);
    hipDeviceGetAttribute(&cus, hipDeviceAttributeMultiprocessorCount, dev);
    if (hipFuncSetAttribute((const void*)mega, hipFuncAttributeMaxDynamicSharedMemorySize, LDS_BYTES) != hipSuccess) { grid_blocks = -1; return; }
    if (hipOccupancyMaxActiveBlocksPerMultiprocessor(&per_cu, (const void*)mega, 512, LDS_BYTES) != hipSuccess || per_cu < 1) per_cu = 1;
    per_cu = 1;
    grid_blocks = cus * per_cu;
    grid_blocks &= ~7;
    fprintf(stderr, "kernel_launch: cus %d per_cu %d grid %d\n", cus, per_cu, grid_blocks);
  }
  if (grid_blocks < 0) return;
  Params p{};
  Ctx& c = p.c;
  c.x = (const float*)d_in[0]; c.rel_bias = (const float*)d_in[1]; c.norm_mix = (const float*)d_in[2]; c.norm_mlp = (const float*)d_in[3];
  c.a_q_gain = (const float*)d_in[7]; c.a_k_gain = (const float*)d_in[8];
  c.b_q_gain = (const float*)d_in[11]; c.b_k_gain = (const float*)d_in[12];
  c.c_conv_w = (const float*)d_in[15]; c.c_a_log = (const float*)d_in[16]; c.c_dt_bias = (const float*)d_in[17]; c.c_o_gain = (const float*)d_in[18];
  c.wbase[0] = (const float*)d_in[6]; c.wbase[1] = (const float*)d_in[9]; c.wbase[2] = (const float*)d_in[10]; c.wbase[3] = (const float*)d_in[13];
  c.wbase[4] = (const float*)d_in[14]; c.wbase[5] = (const float*)d_in[19]; c.wbase[6] = (const float*)d_in[4]; c.wbase[7] = (const float*)d_in[5];
  c.out = (float*)d_out; c.ws = (char*)d_ws;
  int np = 0;
  bool x_in_out = false;
  auto add = [&](int op, int l, int half) {
    int rep = 1;
    if (op == OP_GEMM_W1) rep = REP_W1;
    if (op == OP_MIX_B) rep = half ? REP_MIXB2 : REP_MIXB;
    if (op == OP_PREP_C) rep = REP_C;
    if (op == OP_SCAN_C) rep = REP_SCAN;
    if (op == OP_ATTN_A) rep = REP_ATTN;
    if (op == OP_NORM_MLP || op == OP_NORM_MIX) rep = REP_NORM;
    for (int r = 0; r < rep; ++r) p.ops[np++] = (unsigned char)(op | (l << 4) | (half << 6) | (x_in_out ? 0 : 128));
    if (op == OP_GEMM_OUT || op == OP_GEMM_W2) x_in_out = true;
  };
  add(OP_CONVERT, 0, (MIXMASK & 1) ? 1 : 0);
#ifdef REP_SYNC
  for (int q = 0; q < REP_SYNC; ++q) p.ops[np++] = 15;
#endif
  for (int l = 0; l < 4; ++l) {
    const int kind = l % 3;
    if ((MIXMASK >> l) & 1) {
      add(OP_NORM_MIX, l, 0);
      if (kind == 0) { add(OP_GEMM_IN, l, 0); add(OP_ATTN_A, l, 0); add(OP_COMBINE_A, l, 0); add(OP_GEMM_OUT, l, 0); }
      else if (kind == 1) { add(OP_GEMM_IN, l, 0); add(OP_MIX_B, l, 0); add(OP_MIX_B, l, 1); add(OP_GEMM_OUT, l, 0); }
      else { add(OP_GEMM_IN, l, 0); add(OP_PREP_C, l, 0); add(OP_SCAN_GEMM, l, 0); add(OP_PREP_C, l, 1); add(OP_SCAN_C, l, 1); add(OP_OUTNORM_C, l, 0); add(OP_GEMM_OUT, l, 0); }
    }
    add(OP_NORM_MLP, l, 0); add(OP_GEMM_W1, l, 0); add(OP_GEMM_W2, l, 0);
  }
#if MULTI_LAUNCH
  for (int i = 0; i < np; ++i) {
    p.ph0 = i; p.ph1 = i + 1;
    hipLaunchKernelGGL(mega, dim3(grid_blocks), dim3(512), LDS_BYTES, stream, p);
  }
#else
  p.ph0 = 0; p.ph1 = np;
  (void)hipMemsetAsync((char*)d_ws + WS_BAR, 0, XCD_BAR_WORDS * 4, stream);
  void* args[] = {&p};
  hipError_t e = hipLaunchCooperativeKernel((const void*)mega, dim3(grid_blocks), dim3(512), args, LDS_BYTES, stream);
  if (e != hipSuccess) fprintf(stderr, "cooperative launch failed: %s (grid %d)\n", hipGetErrorString(e), grid_blocks);
#endif
}
```
